# Optimizing an MI355X kernel written in HIP

```python
import math
import jax, jax.numpy as jnp
from jax import lax
import numpy as np

D_MODEL = 1024
BATCH = 8
SEQ = 8192
DEPTH = 4

D_MIX = D_MODEL
DN_HEADS = 4
DN_HEAD_DIM = 128
DN_WIDTH = DN_HEADS * DN_HEAD_DIM
DN_CONV = 4
CHUNK = 64
SC_WIDTH = D_MIX - DN_WIDTH
SC_GROUPS = 4
SC_GROUP_DIM = SC_WIDTH // SC_GROUPS
SC_CONV = 3
D_FF = ((8 * D_MODEL + 3 * 256 - 1) // (3 * 256)) * 256
W_IN_COLS = 4 * DN_WIDTH + 2 * DN_HEADS + 3 * SC_WIDTH
EPS = 1e-6

kernel_name = 'hybrid_gdn_shortconv_swiglu'


def rms_norm(x, gain):
    xf = x.astype(jnp.float32)
    y = xf * lax.rsqrt(jnp.mean(xf * xf, axis=-1, keepdims=True) + EPS)
    return (y * gain.astype(jnp.float32)).astype(x.dtype)


def l2_normalize(x):
    return x * lax.rsqrt(jnp.sum(x * x, axis=-1, keepdims=True) + EPS)


def causal_depthwise_conv(x, w):
    K = w.shape[0]
    T = x.shape[1]
    xp = jnp.pad(x, ((0, 0), (K - 1, 0), (0, 0)))
    y = xp[:, 0:T, :] * w[0]
    for j in range(1, K):
        y = y + xp[:, j:j + T, :] * w[j]
    return y


def chunk_gated_delta_rule(q, k, v, g, beta):
    Bsz, T, H, DK = q.shape
    DV = v.shape[-1]
    C = CHUNK
    N = T // C
    q = q * (DK ** -0.5)

    def to_chunks(t):
        return t.reshape(Bsz, N, C, H, t.shape[-1]).transpose(0, 3, 1, 2, 4)

    q, k, v = to_chunks(q), to_chunks(k), to_chunks(v)
    g = jnp.cumsum(g.reshape(Bsz, N, C, H).transpose(0, 3, 1, 2), axis=-1)
    beta = beta.reshape(Bsz, N, C, H).transpose(0, 3, 1, 2)

    causal = jnp.tril(jnp.ones((C, C), dtype=bool))
    strict = jnp.tril(jnp.ones((C, C), dtype=bool), -1)
    decay = jnp.exp(jnp.where(causal, g[..., :, None] - g[..., None, :], -jnp.inf))

    k_beta = k * beta[..., None]
    v_beta = v * beta[..., None]
    lower = jnp.where(strict, jnp.einsum('bhncd,bhnmd->bhncm', k_beta, k) * decay, 0.0)
    a_mat = lower + jnp.eye(C, dtype=jnp.float32)
    rhs = jnp.concatenate([v_beta, k_beta * jnp.exp(g)[..., None]], axis=-1)
    sol = lax.linalg.triangular_solve(a_mat, rhs, left_side=True, lower=True, unit_diagonal=True)
    u, w = sol[..., :DV], sol[..., DV:]

    qk = jnp.einsum('bhncd,bhnmd->bhncm', q, k) * decay
    q_dec = q * jnp.exp(g)[..., None]
    k_dec = k * jnp.exp(g[..., -1:] - g)[..., None]
    g_last = jnp.exp(g[..., -1])

    def step(S, xs):
        qk_i, q_dec_i, k_dec_i, u_i, w_i, gl_i = xs
        v_new = u_i - jnp.einsum('bhck,bhkv->bhcv', w_i, S)
        o_i = jnp.einsum('bhck,bhkv->bhcv', q_dec_i, S) + jnp.einsum('bhcm,bhmv->bhcv', qk_i, v_new)
        S = S * gl_i[..., None, None] + jnp.einsum('bhck,bhcv->bhkv', k_dec_i, v_new)
        return S, o_i

    xs = (jnp.moveaxis(qk, 2, 0), jnp.moveaxis(q_dec, 2, 0), jnp.moveaxis(k_dec, 2, 0),
          jnp.moveaxis(u, 2, 0), jnp.moveaxis(w, 2, 0), jnp.moveaxis(g_last, 2, 0))
    S0 = jnp.zeros((Bsz, H, DK, DV), dtype=jnp.float32)
    _, o = lax.scan(step, S0, xs)
    return o.transpose(1, 0, 3, 2, 4).reshape(Bsz, T, H, DV)


def hybrid_layer(x, norm1_g, w_in, dn_conv_w, dn_a_log, dn_dt_bias, dn_norm_g,
                 sc_conv_w, sc_norm_g, w_out, norm2_g, ffn_w_gate, ffn_w_up, ffn_w_down):
    Bsz, T, _ = x.shape
    h = rms_norm(x, norm1_g)
    proj = h @ w_in
    o1 = 3 * DN_WIDTH
    o2 = o1 + DN_WIDTH
    o3 = o2 + DN_HEADS
    o4 = o3 + DN_HEADS
    qkv, z, b_in, a_in, sc_in = proj[..., :o1], proj[..., o1:o2], proj[..., o2:o3], proj[..., o3:o4], proj[..., o4:]

    qkv = jax.nn.silu(causal_depthwise_conv(qkv, dn_conv_w)).astype(jnp.float32)
    q = l2_normalize(qkv[..., :DN_WIDTH].reshape(Bsz, T, DN_HEADS, DN_HEAD_DIM))
    k = l2_normalize(qkv[..., DN_WIDTH:2 * DN_WIDTH].reshape(Bsz, T, DN_HEADS, DN_HEAD_DIM))
    v = qkv[..., 2 * DN_WIDTH:].reshape(Bsz, T, DN_HEADS, DN_HEAD_DIM)
    beta = jax.nn.sigmoid(b_in.astype(jnp.float32))
    g = -jnp.exp(dn_a_log.astype(jnp.float32)) * jax.nn.softplus(
        a_in.astype(jnp.float32) + dn_dt_bias.astype(jnp.float32))
    o_dn = chunk_gated_delta_rule(q, k, v, g, beta)
    zf = z.astype(jnp.float32).reshape(Bsz, T, DN_HEADS, DN_HEAD_DIM)
    o_dn = (o_dn * lax.rsqrt(jnp.mean(o_dn * o_dn, axis=-1, keepdims=True) + EPS)
            * dn_norm_g.astype(jnp.float32) * jax.nn.silu(zf))
    o_dn = o_dn.reshape(Bsz, T, DN_WIDTH).astype(x.dtype)

    gate_b, gate_c, hv = sc_in[..., :SC_WIDTH], sc_in[..., SC_WIDTH:2 * SC_WIDTH], sc_in[..., 2 * SC_WIDTH:]
    y = gate_b * causal_depthwise_conv(gate_c * hv, sc_conv_w)
    yf = y.astype(jnp.float32).reshape(Bsz, T, SC_GROUPS, SC_GROUP_DIM)
    yf = yf * lax.rsqrt(jnp.mean(yf * yf, axis=-1, keepdims=True) + EPS)
    o_sc = (yf * sc_norm_g.astype(jnp.float32).reshape(SC_GROUPS, SC_GROUP_DIM)).reshape(Bsz, T, SC_WIDTH).astype(x.dtype)

    x = x + jnp.concatenate([o_dn, o_sc], axis=-1) @ w_out

    h2 = rms_norm(x, norm2_g)
    x = x + (jax.nn.silu(h2 @ ffn_w_gate) * (h2 @ ffn_w_up)) @ ffn_w_down
    return x


def setup_inputs(seed: int = 0) -> dict:
    key = jax.random.key(seed)
    ks = jax.random.split(key, 16)
    f32 = jnp.float32

    def nrm(k, shape, scale):
        return jax.random.normal(k, shape, f32) * scale

    def gain(k, shape):
        return 1.0 + 0.02 * jax.random.normal(k, shape, f32)

    x = nrm(ks[0], (BATCH, SEQ, D_MODEL), 1.0)
    norm1_g = gain(ks[1], (DEPTH, D_MODEL))
    w_in = nrm(ks[2], (DEPTH, D_MODEL, W_IN_COLS), D_MODEL ** -0.5)
    dn_conv_w = nrm(ks[3], (DEPTH, DN_CONV, 3 * DN_WIDTH), DN_CONV ** -0.5)
    dn_a_log = jnp.log(jax.random.uniform(ks[4], (DEPTH, DN_HEADS), f32, 1.0, 16.0))
    dt = jnp.exp(jax.random.uniform(ks[5], (DEPTH, DN_HEADS), f32, math.log(1e-3), math.log(1e-1)))
    dn_dt_bias = dt + jnp.log(-jnp.expm1(-dt))
    dn_norm_g = gain(ks[6], (DEPTH, DN_HEAD_DIM))
    sc_conv_w = nrm(ks[7], (DEPTH, SC_CONV, SC_WIDTH), SC_CONV ** -0.5)
    sc_norm_g = gain(ks[8], (DEPTH, SC_WIDTH))
    w_out = nrm(ks[9], (DEPTH, D_MIX, D_MODEL), D_MIX ** -0.5)
    norm2_g = gain(ks[10], (DEPTH, D_MODEL))
    ffn_w_gate = nrm(ks[11], (DEPTH, D_MODEL, D_FF), D_MODEL ** -0.5)
    ffn_w_up = nrm(ks[12], (DEPTH, D_MODEL, D_FF), D_MODEL ** -0.5)
    ffn_w_down = nrm(ks[13], (DEPTH, D_FF, D_MODEL), D_FF ** -0.5)
    final_norm_g = gain(ks[14], (D_MODEL,))
    return {'x': x, 'norm1_g': norm1_g, 'w_in': w_in, 'dn_conv_w': dn_conv_w,
            'dn_a_log': dn_a_log, 'dn_dt_bias': dn_dt_bias, 'dn_norm_g': dn_norm_g,
            'sc_conv_w': sc_conv_w, 'sc_norm_g': sc_norm_g, 'w_out': w_out,
            'norm2_g': norm2_g, 'ffn_w_gate': ffn_w_gate, 'ffn_w_up': ffn_w_up,
            'ffn_w_down': ffn_w_down, 'final_norm_g': final_norm_g}


def reference(x, norm1_g, w_in, dn_conv_w, dn_a_log, dn_dt_bias, dn_norm_g, sc_conv_w,
              sc_norm_g, w_out, norm2_g, ffn_w_gate, ffn_w_up, ffn_w_down, final_norm_g):
    for l in range(DEPTH):
        x = hybrid_layer(x, norm1_g[l], w_in[l], dn_conv_w[l], dn_a_log[l], dn_dt_bias[l],
                         dn_norm_g[l], sc_conv_w[l], sc_norm_g[l], w_out[l], norm2_g[l],
                         ffn_w_gate[l], ffn_w_up[l], ffn_w_down[l])
    return rms_norm(x, final_norm_g)
```

```cpp
#include <hip/hip_runtime.h>
#include <hip/hip_cooperative_groups.h>
#include <cstdio>
#include <cstdint>
namespace cg = cooperative_groups;
namespace pg8 {
#define PG8_LAS __attribute__((address_space(3)))
typedef unsigned short bf16_t;
typedef short bf16x8 __attribute__((ext_vector_type(8)));
typedef float f32x4 __attribute__((ext_vector_type(4)));
typedef unsigned u32x4 __attribute__((ext_vector_type(4)));
constexpr int BM = 256, BK = 64, HALF = 128, HTB = HALF * BK * 2  , STAGE_BYTES = 8 * HTB, NXCD = 8, WGM = 8;

__host__ __device__ __forceinline__ int lds_byte(int r, int c) { const int st = (r >> 4) * 2 + (c >> 5), rr = r & 15, cc = c & 31, ob = rr * 64 + cc * 2; return st * 1024 + (ob ^ (((ob >> 9) & 1) << 5)); }
__host__ __device__ __forceinline__ void stage_rc(int b, int& R, int& C) { const int st = b / 1024, sb = b % 1024, swz = sb ^ (((sb >> 9) & 1) << 5); R = (st >> 1) * 16 + swz / 64; C = (st & 1) * 32 + (swz % 64) / 2; }
__host__ __device__ __forceinline__ int perm32(int rho) { const int n = rho >> 4, i = rho & 15; return 8 * (i >> 2) + 4 * n + (i & 3); }

struct Unit { int pm, pn; };
struct Gemm { const bf16_t* A; const bf16_t* Bt; int M, N, K; };

struct StaticOrder {
    int nM, nN, nwg, G, c;
    __host__ __device__ void init(int M, int N, int G_, int c_) { nM = M / BM; nN = N / BM; nwg = nM * nN; G = G_; c = c_; }
    __host__ __device__ bool next(int i, Unit& u) const {
        const long L = (long)i * G + c; if (L >= nwg) return false;
        int wgid = (int)L; { const int q = nwg / NXCD, r = nwg % NXCD, xcd = wgid % NXCD, off = wgid / NXCD; wgid = (xcd < r ? xcd * (q + 1) : r * (q + 1) + (xcd - r) * q) + off; }
        const int nig = WGM * nN, gid = wgid / nig, fm = gid * WGM, gsz = (nM - fm) < WGM ? (nM - fm) : WGM;
        u.pm = fm + ((wgid % nig) % gsz); u.pn = (wgid % nig) / gsz; return true;
    }
    __device__ __forceinline__ void a_ready(const Unit&) const {}
    __device__ __forceinline__ void done(const Unit&) const {}
};

typedef float f32x2 __attribute__((ext_vector_type(2)));
typedef __bf16 bf16x2_t __attribute__((ext_vector_type(2)));
__device__ __forceinline__ unsigned pk_bf16(float lo, float hi) { f32x2 v = {lo, hi}; bf16x2_t b = __builtin_convertvector(v, bf16x2_t); return __builtin_bit_cast(unsigned, b); }
__device__ __forceinline__ float sigmoid_f(float x) { return __builtin_amdgcn_rcpf(1.0f + __expf(-x)); }
__device__ __forceinline__ float row_rs(const float* ssp, int row) {
    const f32x4* p = (const f32x4*)(ssp + (size_t)row * 16); const f32x4 a = p[0], b = p[1], c = p[2], d = p[3];
    const float s = (((a.x + a.y) + (a.z + a.w)) + ((b.x + b.y) + (b.z + b.w))) + (((c.x + c.y) + (c.z + c.w)) + ((d.x + d.y) + (d.z + d.w)));
    return rsqrtf(s * (1.0f / 1024.0f) + 1e-6f);
}

__device__ __forceinline__ void row_rs8(const float* ssp, int row0, int fq, float (&rr)[8]) {
    f32x4 pv[8];
#pragma unroll
    for (int k = 0; k < 8; ++k) pv[k] = *(const f32x4*)(ssp + (size_t)(row0 + (k >> 2) * HALF + (k & 3) * 16) * 16 + 4 * fq);
#pragma unroll
    for (int k = 0; k < 8; ++k) { float s = (pv[k].x + pv[k].y) + (pv[k].z + pv[k].w); s += __shfl_xor(s, 16); s += __shfl_xor(s, 32); rr[k] = rsqrtf(s * (1.0f / 1024.0f) + 1e-6f); }
}

struct EpiInProj {
    static constexpr bool PERM = true, AFTER_DRAIN = false;
    bf16_t* PA; bf16_t* PZ; bf16_t* PS; float* BG; const float* ss; const float* a_log; const float* dt_bias;
    __device__ __forceinline__ void operator()(const f32x4 (&acc)[2][2][4][2], const Unit& u, int wr, int wc, int fr, int fq) const {
        const int row0 = u.pm * BM + wr * 64 + fr;
        float rr[8]; row_rs8(ss, row0, fq, rr);
        if (u.pn < 14) {
            bf16_t* base; int ldc, colt;
            if (u.pn < 6) { base = PA; ldc = 1536; colt = u.pn * 256; }
            else if (u.pn < 8) { base = PZ; ldc = 512; colt = (u.pn - 6) * 256; }
            else { base = PS; ldc = 1536; colt = (u.pn - 8) * 256; }
            const int col0 = colt + wc * 32 + 8 * fq;
#pragma unroll
            for (int ai = 0; ai < 2; ++ai)
#pragma unroll
                for (int m = 0; m < 4; ++m) {
                    const int row = row0 + ai * HALF + m * 16;
                    const float r = rr[ai * 4 + m];
                    bf16_t* rowp = base + (size_t)row * ldc + col0;
#pragma unroll
                    for (int bj = 0; bj < 2; ++bj) {
                        const f32x4 v0 = acc[ai][bj][m][0] * r, v1 = acc[ai][bj][m][1] * r;
                        u32x4 w; w.x = pk_bf16(v0[0], v0[1]); w.y = pk_bf16(v0[2], v0[3]); w.z = pk_bf16(v1[0], v1[1]); w.w = pk_bf16(v1[2], v1[3]);
                        *(u32x4*)(rowp + bj * HALF) = w;
                    }
                }
        } else if (wc == 0) {
            if (fq == 0) {
                const f32x4 al = *(const f32x4*)a_log, db = *(const f32x4*)dt_bias;
                const f32x4 ea = {__expf(al[0]), __expf(al[1]), __expf(al[2]), __expf(al[3])};
#pragma unroll
                for (int ai = 0; ai < 2; ++ai)
#pragma unroll
                    for (int m = 0; m < 4; ++m) {
                        const int row = row0 + ai * HALF + m * 16;
                        const float r = rr[ai * 4 + m];
                        const f32x4 bi = acc[ai][0][m][0] * r, av = acc[ai][0][m][1] * r;
                        f32x4 be, gg;
#pragma unroll
                        for (int h = 0; h < 4; ++h) {
                            be[h] = __builtin_amdgcn_rcpf(1.0f + __expf(-bi[h]));
                            const float xx = av[h] + db[h], ee = __expf(xx);
                            const float sp = xx > 20.f ? xx : (ee < 0.03f ? ee * (1.0f - ee * (0.5f - ee * (0.33333334f - 0.25f * ee))) : __logf(1.0f + ee));
                            gg[h] = -ea[h] * sp;
                        }
                        *(f32x4*)(BG + (size_t)row * 8) = be; *(f32x4*)(BG + (size_t)row * 8 + 4) = gg;
                    }
            }
        }
    }
};

struct EpiResid {
    static constexpr bool PERM = true, AFTER_DRAIN = false;
    bf16_t* xb; float* ss;
    __device__ __forceinline__ void operator()(const f32x4 (&acc)[2][2][4][2], const Unit& u, int wr, int wc, int fr, int fq) const {
        const int row0 = u.pm * BM + wr * 64 + fr, col0 = u.pn * BM + wc * 32 + 8 * fq;
        u32x4 xin[8][2];
#pragma unroll
        for (int k = 0; k < 8; ++k)
#pragma unroll
            for (int bj = 0; bj < 2; ++bj) xin[k][bj] = *(const u32x4*)(xb + (size_t)(row0 + (k >> 2) * HALF + (k & 3) * 16) * 1024 + col0 + bj * HALF);
#pragma unroll
        for (int ai = 0; ai < 2; ++ai)
#pragma unroll
            for (int m = 0; m < 4; ++m) {
                const int row = row0 + ai * HALF + m * 16; const size_t off = (size_t)row * 1024 + col0;
                float sq = 0.f;
#pragma unroll
                for (int bj = 0; bj < 2; ++bj) {
                    const u32x4 xv = xin[ai * 4 + m][bj];
                    const f32x4 a0 = acc[ai][bj][m][0], a1 = acc[ai][bj][m][1];
                    u32x4 w;
                    w.x = pk_bf16(__uint_as_float(xv.x << 16) + a0[0], __uint_as_float(xv.x & 0xffff0000u) + a0[1]);
                    w.y = pk_bf16(__uint_as_float(xv.y << 16) + a0[2], __uint_as_float(xv.y & 0xffff0000u) + a0[3]);
                    w.z = pk_bf16(__uint_as_float(xv.z << 16) + a1[0], __uint_as_float(xv.z & 0xffff0000u) + a1[1]);
                    w.w = pk_bf16(__uint_as_float(xv.w << 16) + a1[2], __uint_as_float(xv.w & 0xffff0000u) + a1[3]);
                    *(u32x4*)(xb + off + bj * HALF) = w;
                    const float r0 = __uint_as_float(w.x << 16), r1 = __uint_as_float(w.x & 0xffff0000u), r2 = __uint_as_float(w.y << 16), r3 = __uint_as_float(w.y & 0xffff0000u);
                    const float r4 = __uint_as_float(w.z << 16), r5 = __uint_as_float(w.z & 0xffff0000u), r6 = __uint_as_float(w.w << 16), r7 = __uint_as_float(w.w & 0xffff0000u);
                    sq += ((r0 * r0 + r1 * r1) + (r2 * r2 + r3 * r3)) + ((r4 * r4 + r5 * r5) + (r6 * r6 + r7 * r7));
                }
                sq += __shfl_xor(sq, 16); sq += __shfl_xor(sq, 32);
                if (fq == 0) ss[(size_t)row * 16 + u.pn * 4 + wc] = sq;
                asm volatile("" ::: "memory");
            }
    }
};

struct EpiSwiGLU {
    static constexpr bool PERM = true, AFTER_DRAIN = false;
    bf16_t* act; const float* ss;
    __device__ __forceinline__ void operator()(const f32x4 (&acc)[2][2][4][2], const Unit& u, int wr, int wc, int fr, int fq) const {
        const int row0 = u.pm * BM + wr * 64 + fr, col0 = u.pn * HALF + wc * 32 + 8 * fq;
        float rr[8]; row_rs8(ss, row0, fq, rr);
#pragma unroll
        for (int ai = 0; ai < 2; ++ai)
#pragma unroll
            for (int m = 0; m < 4; ++m) {
                const int row = row0 + ai * HALF + m * 16;
                const float r = rr[ai * 4 + m];
                float o[8];
#pragma unroll
                for (int n = 0; n < 2; ++n)
#pragma unroll
                    for (int j = 0; j < 4; ++j) { const float g = acc[ai][0][m][n][j] * r, up = acc[ai][1][m][n][j] * r; o[n * 4 + j] = g * sigmoid_f(g) * up; }
                u32x4 w; w.x = pk_bf16(o[0], o[1]); w.y = pk_bf16(o[2], o[3]); w.z = pk_bf16(o[4], o[5]); w.w = pk_bf16(o[6], o[7]);
                *(u32x4*)(act + (size_t)row * 2816 + col0) = w;
            }
    }
};

template <class Epi, class Sched, bool ALIGN_EPI = false, bool SP2 = false>
__device__ __forceinline__ void gemm_phase(PG8_LAS unsigned char* lds, const Gemm g, const Sched& S, const Epi& E, int tid_arg) {
    int tid_l = tid_arg; asm volatile("" : "+v"(tid_l));
    const int tid = tid_l, wid = __builtin_amdgcn_readfirstlane(tid >> 6), lane = tid & 63, wr = wid >> 2, wc = wid & 3, fr = lane & 15, fq = lane >> 4;
    const int K = g.K, nt = K / BK;
    unsigned voffA[2], voffB[2];
#pragma unroll
    for (int i = 0; i < 2; ++i) { int R, C; stage_rc(tid * 16 + i * 8192, R, C); const int Rb = Epi::PERM ? ((R & ~31) + perm32(R & 31)) : R;
        voffA[i] = (unsigned)(R * K + C) * 2u; voffB[i] = (unsigned)(Rb * K + C) * 2u; }
    const size_t kstep = (size_t)(BK * 2);
    const size_t hstep = (size_t)HALF * K * 2;
    const size_t tstep = 2 * hstep;
    const unsigned ldsw = (unsigned)wid * 1024u;
    const int aoff = lds_byte(wr * 64 + fr, fq * 8), boff = lds_byte(wc * 32 + fr, fq * 8);
#define PG8_SA(b, h) (((b) * 2 + (h)) * HTB)
#define PG8_SB(b, h) ((4 + (b) * 2 + (h)) * HTB)
#define PG8_STAGE(bufoff, gbase, voff) do { _Pragma("unroll") for (int _i = 0; _i < 2; ++_i) \
        __builtin_amdgcn_global_load_lds((const unsigned*)((const char*)(gbase) + (voff)[_i]), (PG8_LAS unsigned*)(lds + (bufoff) + ldsw + _i * 8192), 16, 0, 0); } while (0)
#define PG8_LDA(dst, b, h) do { _Pragma("unroll") for (int m = 0; m < 4; ++m) _Pragma("unroll") for (int k = 0; k < 2; ++k) dst[m][k] = *(const PG8_LAS bf16x8*)(lds + PG8_SA(b, h) + aoff + m * 2048 + k * 1024); } while (0)
#define PG8_LDB(dst, b, h) do { _Pragma("unroll") for (int n = 0; n < 2; ++n) _Pragma("unroll") for (int k = 0; k < 2; ++k) dst[n][k] = *(const PG8_LAS bf16x8*)(lds + PG8_SB(b, h) + boff + n * 2048 + k * 1024); } while (0)
#define PG8_MMA(ai, bj, At, Bt) do { __builtin_amdgcn_s_setprio(1); _Pragma("unroll") for (int m = 0; m < 4; ++m) _Pragma("unroll") for (int n = 0; n < 2; ++n) _Pragma("unroll") for (int k = 0; k < 2; ++k) \
        acc[ai][bj][m][n] = __builtin_amdgcn_mfma_f32_16x16x32_bf16(Bt[n][k], At[m][k], acc[ai][bj][m][n], 0, 0, 0); __builtin_amdgcn_s_setprio(0); } while (0)
#define PG8_WAIT_V(n) asm volatile("s_waitcnt vmcnt(" #n ")" ::: "memory")
#define PG8_WAIT_L(n) asm volatile("s_waitcnt lgkmcnt(" #n ")" ::: "memory")
#define PG8_BAR __builtin_amdgcn_s_barrier()
#define PG8_SCHED __builtin_amdgcn_sched_barrier(0)
    Unit cur, nxt; int ui = 0;
    if (!S.next(0, cur)) return;
    f32x4 acc[2][2][4][2];
#pragma unroll
    for (int a = 0; a < 2; ++a)
#pragma unroll
        for (int b = 0; b < 2; ++b)
#pragma unroll
            for (int m = 0; m < 4; ++m)
#pragma unroll
                for (int n = 0; n < 2; ++n) acc[a][b][m][n] = (f32x4){0.f, 0.f, 0.f, 0.f};
    bf16x8 At[4][2], B0[2][2], B1[2][2];
    const char* cA = (const char*)g.A + (size_t)cur.pm * tstep; const char* cB = (const char*)g.Bt + (size_t)cur.pn * tstep;
    S.a_ready(cur);
    if constexpr (SP2) {
        PG8_STAGE(PG8_SB(0, 0), cB, voffB); PG8_STAGE(PG8_SB(0, 1), cB + hstep, voffB); PG8_STAGE(PG8_SA(0, 0), cA, voffA); PG8_STAGE(PG8_SA(0, 1), cA + hstep, voffA);
        if (wr == 1) PG8_BAR;
        PG8_WAIT_V(2); PG8_BAR;
        PG8_STAGE(PG8_SB(1, 0), cB + kstep, voffB); PG8_STAGE(PG8_SA(1, 0), cA + kstep, voffA); PG8_STAGE(PG8_SB(1, 1), cB + hstep + kstep, voffB);
        PG8_WAIT_V(6); PG8_BAR;
    } else {
        PG8_STAGE(PG8_SB(0, 0), cB, voffB); PG8_STAGE(PG8_SA(0, 0), cA, voffA); PG8_STAGE(PG8_SB(0, 1), cB + hstep, voffB); PG8_STAGE(PG8_SA(0, 1), cA + hstep, voffA);
        if (wr == 1) PG8_BAR;
        PG8_WAIT_V(4); PG8_BAR;
        PG8_STAGE(PG8_SB(1, 0), cB + kstep, voffB); PG8_STAGE(PG8_SA(1, 0), cA + kstep, voffA); PG8_STAGE(PG8_SB(1, 1), cB + hstep + kstep, voffB);
        PG8_WAIT_V(6); PG8_BAR;
    }
    for (;;) {
        const bool has_next = S.next(ui + 1, nxt);
        const char* nA = has_next ? (const char*)g.A + (size_t)nxt.pm * tstep : cA; const char* nB = has_next ? (const char*)g.Bt + (size_t)nxt.pn * tstep : cB;
        for (int t = 0; t < nt; t += 2) {
            const bool last = (t == nt - 2);
            const char* a1 = cA + (size_t)(t + 1) * kstep;
            const char* a2 = last ? nA : cA + (size_t)(t + 2) * kstep; const char* b2 = last ? nB : cB + (size_t)(t + 2) * kstep;
            const char* a3 = a2 + kstep; const char* b3 = b2 + kstep;
            if (last && has_next) S.a_ready(nxt);
            if constexpr (SP2) {
            PG8_LDB(B0, 0, 0); PG8_LDB(B1, 0, 1); PG8_SCHED; PG8_LDA(At, 0, 0); PG8_STAGE(PG8_SA(1, 1), a1 + hstep, voffA);
            PG8_WAIT_V(8); PG8_WAIT_L(0); PG8_BAR; PG8_MMA(0, 0, At, B0); PG8_MMA(0, 1, At, B1); PG8_BAR; PG8_SCHED;
            PG8_LDA(At, 0, 1); PG8_STAGE(PG8_SB(0, 0), b2, voffB); PG8_STAGE(PG8_SB(0, 1), b2 + hstep, voffB); PG8_STAGE(PG8_SA(0, 0), a2, voffA);
            PG8_WAIT_V(8); PG8_WAIT_L(0); PG8_BAR; PG8_MMA(1, 0, At, B0); PG8_MMA(1, 1, At, B1); PG8_BAR; PG8_SCHED;
            PG8_LDB(B0, 1, 0); PG8_LDB(B1, 1, 1); PG8_SCHED; PG8_LDA(At, 1, 0); PG8_STAGE(PG8_SA(0, 1), a2 + hstep, voffA);
            PG8_WAIT_V(8); PG8_WAIT_L(0); PG8_BAR; PG8_MMA(0, 0, At, B0); PG8_MMA(0, 1, At, B1); PG8_BAR; PG8_SCHED;
            PG8_LDA(At, 1, 1); PG8_STAGE(PG8_SB(1, 0), b3, voffB); PG8_STAGE(PG8_SB(1, 1), b3 + hstep, voffB); PG8_STAGE(PG8_SA(1, 0), a3, voffA);
            PG8_WAIT_V(8); PG8_WAIT_L(0); PG8_BAR; PG8_MMA(1, 0, At, B0); PG8_MMA(1, 1, At, B1); PG8_BAR; PG8_SCHED;
            } else {
            PG8_LDB(B0, 0, 0); PG8_SCHED; PG8_LDA(At, 0, 0); PG8_STAGE(PG8_SA(1, 1), a1 + hstep, voffA);
            PG8_WAIT_L(8); PG8_BAR; PG8_WAIT_L(0); PG8_MMA(0, 0, At, B0); PG8_BAR; PG8_SCHED;
            PG8_LDB(B1, 0, 1); PG8_STAGE(PG8_SB(0, 0), b2, voffB);
            PG8_BAR; PG8_WAIT_L(0); PG8_MMA(0, 1, At, B1); PG8_BAR;
            PG8_LDA(At, 0, 1); PG8_STAGE(PG8_SA(0, 0), a2, voffA);
            PG8_BAR; PG8_WAIT_L(0); PG8_MMA(1, 0, At, B0); PG8_BAR; PG8_SCHED;
            PG8_STAGE(PG8_SB(0, 1), b2 + hstep, voffB);
            PG8_WAIT_V(6); PG8_BAR; PG8_MMA(1, 1, At, B1); PG8_BAR;
            PG8_LDB(B0, 1, 0); PG8_SCHED; PG8_LDA(At, 1, 0); PG8_STAGE(PG8_SA(0, 1), a2 + hstep, voffA);
            PG8_WAIT_L(8); PG8_BAR; PG8_WAIT_L(0); PG8_MMA(0, 0, At, B0); PG8_BAR; PG8_SCHED;
            PG8_LDB(B1, 1, 1); PG8_STAGE(PG8_SB(1, 0), b3, voffB);
            PG8_BAR; PG8_WAIT_L(0); PG8_MMA(0, 1, At, B1); PG8_BAR;
            PG8_LDA(At, 1, 1); PG8_STAGE(PG8_SA(1, 0), a3, voffA);
            PG8_BAR; PG8_WAIT_L(0); PG8_MMA(1, 0, At, B0); PG8_BAR; PG8_SCHED;
            PG8_STAGE(PG8_SB(1, 1), b3 + hstep, voffB);
            PG8_WAIT_V(6); PG8_BAR; PG8_MMA(1, 1, At, B1); PG8_BAR;
            }
        }
        if constexpr (ALIGN_EPI) { if (wr == 0) PG8_BAR; }
        if constexpr (!Epi::AFTER_DRAIN) { E(acc, cur, wr, wc, fr, fq); S.done(cur); }
        if (!has_next) break;
#pragma unroll
        for (int a = 0; a < 2; ++a)
#pragma unroll
            for (int b = 0; b < 2; ++b)
#pragma unroll
                for (int m = 0; m < 4; ++m)
#pragma unroll
                    for (int n = 0; n < 2; ++n) acc[a][b][m][n] = (f32x4){0.f, 0.f, 0.f, 0.f};
        cur = nxt; cA = nA; cB = nB; ++ui;
        if constexpr (ALIGN_EPI) { if (wr == 1) PG8_BAR; }
    }
    PG8_WAIT_V(0);
    if constexpr (!ALIGN_EPI) { if (wr == 0) PG8_BAR; }
    PG8_BAR;
    if constexpr (Epi::AFTER_DRAIN) { E.fused(acc, cur, wr, wc, fr, fq, lds, wid, lane); S.done(cur); }
#undef PG8_SA
#undef PG8_SB
#undef PG8_STAGE
#undef PG8_LDA
#undef PG8_LDB
#undef PG8_MMA
#undef PG8_WAIT_V
#undef PG8_WAIT_L
#undef PG8_BAR
#undef PG8_SCHED
}
}

#define LAS __attribute__((address_space(3)))
typedef unsigned short bf16;
typedef unsigned u32x4 __attribute__((ext_vector_type(4)));
typedef unsigned u32x2 __attribute__((ext_vector_type(2)));
typedef float f32x4 __attribute__((ext_vector_type(4)));
typedef float f32x16 __attribute__((ext_vector_type(16)));
typedef short bf16x8 __attribute__((ext_vector_type(8)));
using pg8::pk_bf16;
#define MFMA32(a, b, c) __builtin_amdgcn_mfma_f32_32x32x16_bf16((a), (b), (c), 0, 0, 0)

#ifndef PROBE_M1
#define PROBE_M1 1
#endif
#ifndef PROBE_SCAN
#define PROBE_SCAN 1
#endif
#ifndef PROBE_G1
#define PROBE_G1 1
#endif
#ifndef PROBE_G3
#define PROBE_G3 1
#endif
constexpr int MTOK = 65536, DM = 1024, NLAYER = 4, TSEQ = 8192, FF = 2816, NIN = 3840, NGU = 5632;
constexpr size_t MiB = (size_t)1 << 20;
constexpr size_t WS_CTL = 0, WS_W = 1 * MiB, LW = 27262976, LW_IN = 0, LW_OUT = 7864320, LW_GU = 9961472, LW_DN = 21495808;
constexpr size_t WS_XB = 105 * MiB, WS_SS = 233 * MiB, WS_BG = 234 * MiB, WS_PA = 236 * MiB, WS_MIX = 236 * MiB, WS_PZ = 428 * MiB, WS_PS = 492 * MiB, WS_INTER = 684 * MiB, WS_ACT = 236 * MiB, WS_SSP1 = 972 * MiB, WS_SSP2 = 976 * MiB, WS_END = 980 * MiB;
static_assert(WS_W + 4 * LW <= WS_XB, "weights fit");
constexpr int UNIT_BYTES = 73728;
constexpr int LDS_BYTES = 147456;
constexpr float QSCALE = 0.08838834764831845f;

__device__ __forceinline__ float bf2f(unsigned short v) { return __uint_as_float((unsigned)v << 16); }
__device__ __forceinline__ float bflo(unsigned w) { return __uint_as_float(w << 16); }
__device__ __forceinline__ float bfhi(unsigned w) { return __uint_as_float(w & 0xffff0000u); }
__device__ __forceinline__ unsigned short f2bf(float f) { return (unsigned short)(pk_bf16(f, 0.f) & 0xffffu); }
__device__ __forceinline__ float wave_sum(float v) {
#pragma unroll
    for (int o = 1; o < 64; o <<= 1) v += __shfl_xor(v, o);
    return v;
}
__device__ __forceinline__ float sum16(float v) { v += __shfl_xor(v, 1); v += __shfl_xor(v, 2); v += __shfl_xor(v, 4); v += __shfl_xor(v, 8); return v; }
__device__ __forceinline__ constexpr int crow(int reg, int h) { return (reg & 3) + 8 * (reg >> 2) + 4 * h; }
__device__ __forceinline__ bf16x8 pack_step(const f32x16& x, int s) {
    u32x4 p; p.x = pk_bf16(x[8 * s], x[8 * s + 1]); p.y = pk_bf16(x[8 * s + 2], x[8 * s + 3]); p.z = pk_bf16(x[8 * s + 4], x[8 * s + 5]); p.w = pk_bf16(x[8 * s + 6], x[8 * s + 7]);
    return __builtin_bit_cast(bf16x8, p);
}
#define LDS_WAIT() asm volatile("s_waitcnt lgkmcnt(0)" ::: "memory")
#define LDS_BAR() do { asm volatile("s_waitcnt lgkmcnt(0)" ::: "memory"); __builtin_amdgcn_s_barrier(); asm volatile("" ::: "memory"); } while (0)
__device__ __forceinline__ unsigned char* launder_p(unsigned char* p) { asm volatile("" : "+s"(p)); return p; }
__device__ __forceinline__ int launder_i(int i) { asm volatile("" : "+s"(i)); return i; }
#define INP(k) (a.in[launder_i(k)])
__device__ __forceinline__ int launder_v(int i) { asm volatile("" : "+v"(i)); return i; }
__device__ __forceinline__ int fresh_tid(int wave_s) { unsigned ones = ~0u; asm volatile("" : "+s"(ones)); return (wave_s << 6) | (int)__builtin_amdgcn_mbcnt_hi(ones, __builtin_amdgcn_mbcnt_lo(ones, 0u)); }

__device__ __forceinline__ void transpose_item(const float* W, int ldw, int sc, const float* gain, bf16* dst, int K, int k0, LAS float* scr, int lane) {
    float wv[32];
#pragma unroll
    for (int i = 0; i < 32; ++i) { const int kk = 2 * i + (lane >> 5); wv[i] = 0.f; if (sc >= 0) wv[i] = *(const __attribute__((address_space(1))) float*)(W + (size_t)(k0 + kk) * ldw + sc); }
#pragma unroll
    for (int i = 0; i < 32; ++i) { const int kk = 2 * i + (lane >> 5); float v = wv[i]; if (gain) v *= gain[k0 + kk]; scr[kk * 33 + (lane & 31)] = v; }
    LDS_WAIT(); asm volatile("" ::: "memory");
    const int c = lane & 7;
#pragma unroll
    for (int j = 0; j < 4; ++j) { const int n = (lane >> 3) + 8 * j; const LAS float* s = scr + (8 * c) * 33 + n;
        u32x4 o; o.x = pk_bf16(s[0 * 33], s[1 * 33]); o.y = pk_bf16(s[2 * 33], s[3 * 33]); o.z = pk_bf16(s[4 * 33], s[5 * 33]); o.w = pk_bf16(s[6 * 33], s[7 * 33]);
        *(u32x4*)(dst + (size_t)n * K + k0 + 8 * c) = o; }
    LDS_WAIT(); asm volatile("" ::: "memory");
}

struct Args { const float* in[15]; float* out; unsigned char* ws; };

__device__ __forceinline__ void p0_prologue(const Args& a, LAS unsigned char* lds, int G, int bx, int tid) {
    const int lane = tid & 63, wave = tid >> 6;
    LAS float* scr = (LAS float*)(lds + wave * 16384);
    const int gw = bx * 8 + wave, NGW = G * 8;
    constexpr int I_IN = 16 * 120, I_OUT = 16 * 32, I_GU = 16 * 176, I_DN = 44 * 32, LI = I_IN + I_OUT + I_GU + I_DN;
    unsigned char* wsw = launder_p(a.ws) + WS_W;
    for (int it = gw; it < NLAYER * LI; it += NGW) {
        const int l = it / LI; int r = it % LI; const int cl = lane & 31;
        unsigned char* wl = wsw + (size_t)l * LW;
        if (r < I_IN) { const int kb = r / 120, nb = r % 120, n = nb * 32 + cl;
            const int sc = n < 2048 ? n : (n < 3584 ? n + 8 : (n < 3592 ? n - 3584 + 2048 : -1));
            transpose_item(a.in[2] + (size_t)l * 1024 * 3592, 3592, sc, a.in[1] + l * 1024, (bf16*)(wl + LW_IN) + (size_t)nb * 32 * 1024, 1024, kb * 64, scr, lane); continue; }
        r -= I_IN;
        if (r < I_OUT) { const int kb = r / 32, nb = r % 32;
            transpose_item(a.in[9] + (size_t)l * 1024 * 1024, 1024, nb * 32 + cl, nullptr, (bf16*)(wl + LW_OUT) + (size_t)nb * 32 * 1024, 1024, kb * 64, scr, lane); continue; }
        r -= I_OUT;
        if (r < I_GU) { const int kb = r / 176, nb = r % 176, R0 = nb * 32, pn = R0 >> 8, rr = R0 & 255, bj = rr >> 7, j0 = rr & 127;
            const float* Wsrc = (bj ? a.in[12] : a.in[11]) + (size_t)l * 1024 * 2816;
            transpose_item(Wsrc, 2816, 128 * pn + j0 + cl, a.in[10] + l * 1024, (bf16*)(wl + LW_GU) + (size_t)R0 * 1024, 1024, kb * 64, scr, lane); continue; }
        r -= I_GU;
        { const int kb = r / 32, nb = r % 32;
            transpose_item(a.in[13] + (size_t)l * 2816 * 1024, 1024, nb * 32 + cl, nullptr, (bf16*)(wl + LW_DN) + (size_t)nb * 32 * 2816, 2816, kb * 64, scr, lane); }
    }
    const float* x = a.in[0]; bf16* XB = (bf16*)(a.ws + WS_XB); float* SS1 = (float*)(a.ws + WS_SSP1);
    for (int m = gw; m < MTOK; m += NGW) {
        const f32x4* xr = (const f32x4*)(x + (size_t)m * DM) + lane; f32x4 v[4]; float s = 0.f;
#pragma unroll
        for (int j = 0; j < 4; ++j) { v[j] = xr[64 * j]; s += (v[j].x * v[j].x + v[j].y * v[j].y) + (v[j].z * v[j].z + v[j].w * v[j].w); }
        s = wave_sum(s); if (lane < 16) SS1[(size_t)m * 16 + lane] = lane == 0 ? s : 0.f;
        u32x2* o8 = (u32x2*)(XB + (size_t)m * DM) + lane;
#pragma unroll
        for (int j = 0; j < 4; ++j) { u32x2 o; o.x = pk_bf16(v[j].x, v[j].y); o.y = pk_bf16(v[j].z, v[j].w); o8[64 * j] = o; }
    }
}

constexpr int M1_RAW = 0, M1_AMAT = 0, M1_QKM = 17408, M1_WS = 26624, M1_QS = 51712, M1_KS = 69120, M1_VS = 86528, M1_GC = 103936, M1_BETA = 104192, M1_EG = 104448, M1_BEG = 104704, M1_CW = 106496  , ROWB = 272;

typedef float f32x2v __attribute__((ext_vector_type(2)));
template <int C> struct SolveRows {
    static __device__ __forceinline__ void run(f32x2v (&X2)[32], f32x4 (&cur)[16], LAS unsigned char* lds, const LAS unsigned short* src, const LAS float* fac) {
        f32x4 nxt[16];
#pragma unroll
        for (int q = 0; q < 16; ++q) if (C + 1 < 64 && 4 * q < C + 1) nxt[q] = *(const LAS f32x4*)(lds + M1_AMAT + ((C + 1) * 68 + 4 * q) * 4);
        f32x2v acc0 = {bf2f(src[C * 136]) * fac[C], 0.f}, acc1 = {0.f, 0.f}, acc2 = {0.f, 0.f}, acc3 = {0.f, 0.f};
#pragma unroll
        for (int q = 0; q < 16; ++q) if (4 * q < C) { const f32x4 av = cur[q];
            if (q & 1) { acc2 -= (f32x2v){av.x, av.y} * X2[2 * q]; if (4 * q + 2 < C) acc3 -= (f32x2v){av.z, av.w} * X2[2 * q + 1]; }
            else { acc0 -= (f32x2v){av.x, av.y} * X2[2 * q]; if (4 * q + 2 < C) acc1 -= (f32x2v){av.z, av.w} * X2[2 * q + 1]; } }
        acc0 += acc1; acc2 += acc3; acc0 += acc2;
        float xc = acc0.x + acc0.y;
        asm volatile("" : "+v"(xc) :: "memory");
        X2[C >> 1][C & 1] = xc;
#pragma unroll
        for (int q = 0; q < 16; ++q) if (C + 1 < 64 && 4 * q < C + 1) cur[q] = nxt[q];
        if constexpr (C + 1 < 64) SolveRows<C + 1>::run(X2, cur, lds, src, fac);
    }
};

__device__ __forceinline__ void m1_unit(LAS unsigned char* lds, int unit, const bf16* PA, const float* BG, const float* convw, unsigned char* inter, float* glast, int tid_in) {
    int tid = tid_in; asm volatile("" : "+v"(tid));
    const int b = unit >> 9, n = (unit >> 2) & 127, h = unit & 3;
    const int lane = tid & 63, wave = __builtin_amdgcn_readfirstlane(tid >> 6);
    const size_t row0 = (size_t)b * TSEQ + n * 64;
    LAS float* GC = (LAS float*)(lds + M1_GC); LAS float* BETA = (LAS float*)(lds + M1_BETA); LAS float* EG = (LAS float*)(lds + M1_EG); LAS float* BEG = (LAS float*)(lds + M1_BEG);
    unsigned char* ub = inter + (size_t)unit * UNIT_BYTES;
    float bt = 0.f, gv = 0.f;
    if (wave == 0) { bt = BG[(row0 + lane) * 8 + h]; gv = BG[(row0 + lane) * 8 + 4 + h]; }
    {
        u32x4 rv[7];
#pragma unroll
        for (int it = 0; it < 7; ++it) {
            const int idx = tid + 512 * it, row = idx / 48, rem = idx % 48, seg = rem >> 4, part = rem & 15, t = n * 64 - 3 + row;
            rv[it] = (u32x4){0u, 0u, 0u, 0u};
            if (idx < 67 * 48 && t >= 0) rv[it] = *(const __attribute__((address_space(1))) u32x4*)(PA + ((size_t)b * TSEQ + t) * 1536 + seg * 512 + h * 128 + part * 8);
        }
#pragma unroll
        for (int it = 0; it < 7; ++it) {
            const int idx = tid + 512 * it, row = idx / 48, rem = idx % 48, seg = rem >> 4, part = rem & 15;
            if (idx < 67 * 48) *(LAS u32x4*)(lds + M1_RAW + row * 768 + seg * 256 + part * 16) = rv[it];
        }
    }
    if (wave == 0) {
#pragma unroll
        for (int off = 1; off < 64; off <<= 1) { const int srcl = lane >= off ? lane - off : lane; const float t = __int_as_float(__builtin_amdgcn_ds_bpermute(srcl << 2, __float_as_int(gv))); if (lane >= off) gv += t; }
        const float eg = __expf(gv);
        GC[lane] = gv; BETA[lane] = bt; EG[lane] = eg; BEG[lane] = bt * eg;
    }
    LDS_BAR();
    {
        const int j = tid & 15, cb = tid >> 4;
#pragma unroll 1
        for (int s = 0; s < 3; ++s) {
            float cw[4][8];
#pragma unroll
            for (int tap = 0; tap < 4; ++tap) { const LAS float* wp = (const LAS float*)(lds + M1_CW) + (h * 4 + tap) * 384 + s * 128 + 8 * j; const f32x4 w0 = *(const LAS f32x4*)wp, w1 = *(const LAS f32x4*)(wp + 4);
                cw[tap][0] = w0.x; cw[tap][1] = w0.y; cw[tap][2] = w0.z; cw[tap][3] = w0.w; cw[tap][4] = w1.x; cw[tap][5] = w1.y; cw[tap][6] = w1.z; cw[tap][7] = w1.w; }
            const int dstoff = s == 0 ? M1_QS : (s == 1 ? M1_KS : M1_VS);
#pragma unroll
            for (int pass = 0; pass < 2; ++pass) {
                const int c = cb + 32 * pass; float y[8];
#pragma unroll
                for (int e = 0; e < 8; ++e) y[e] = 0.f;
#pragma unroll
                for (int tap = 0; tap < 4; ++tap) { const u32x4 xv = *(const LAS u32x4*)(lds + M1_RAW + (c + tap) * 768 + s * 256 + j * 16);
                    y[0] += cw[tap][0] * bflo(xv.x); y[1] += cw[tap][1] * bfhi(xv.x); y[2] += cw[tap][2] * bflo(xv.y); y[3] += cw[tap][3] * bfhi(xv.y);
                    y[4] += cw[tap][4] * bflo(xv.z); y[5] += cw[tap][5] * bfhi(xv.z); y[6] += cw[tap][6] * bflo(xv.w); y[7] += cw[tap][7] * bfhi(xv.w); }
                float ssq = 0.f;
#pragma unroll
                for (int e = 0; e < 8; ++e) { y[e] = y[e] * __builtin_amdgcn_rcpf(1.0f + __expf(-y[e])); ssq += y[e] * y[e]; }
                ssq = sum16(ssq);
                const float rn = (s < 2) ? rsqrtf(ssq + 1e-6f) : 1.0f;
                u32x4 o; o.x = pk_bf16(y[0] * rn, y[1] * rn); o.y = pk_bf16(y[2] * rn, y[3] * rn); o.z = pk_bf16(y[4] * rn, y[5] * rn); o.w = pk_bf16(y[6] * rn, y[7] * rn);
                *(LAS u32x4*)(lds + dstoff + c * ROWB + j * 16) = o;
            }
        }
    }
    LDS_BAR();
    {
        const int r = lane & 31, hh = lane >> 5, w4 = wave & 3, ti = w4 >> 1, tj = w4 & 1; const bool isqk = wave >= 4, upper = (ti == 0 && tj == 1);
        if (isqk || !upper) {
            f32x16 x;
#pragma unroll
            for (int i = 0; i < 16; ++i) x[i] = 0.f;
            if (!upper) {
                const LAS unsigned char* Ab = lds + (isqk ? M1_QS : M1_KS) + (32 * ti + r) * ROWB + hh * 16;
                const LAS unsigned char* Bb = lds + M1_KS + (32 * tj + r) * ROWB + hh * 16;
#pragma unroll
                for (int s = 0; s < 8; ++s) { const bf16x8 av = *(const LAS bf16x8*)(Ab + s * 32), bv = *(const LAS bf16x8*)(Bb + s * 32); x = MFMA32(av, bv, x); }
            }
            const int m = 32 * tj + r; const float gm = GC[m];
            float gcv[16], btv[16];
#pragma unroll
            for (int i = 0; i < 16; ++i) { const int c = 32 * ti + crow(i, hh); gcv[i] = GC[c]; btv[i] = BETA[c]; }
#pragma unroll
            for (int i = 0; i < 16; ++i) { const int c = 32 * ti + crow(i, hh); const float dec = __expf(gcv[i] - gm);
                if (!isqk) { const float val = (m < c) ? btv[i] * x[i] * dec : 0.f; *(LAS float*)(lds + M1_AMAT + (c * 68 + m) * 4) = val; }
                else { const float val = (m <= c) ? x[i] * QSCALE * dec : 0.f; *(LAS unsigned short*)(lds + M1_QKM + (c * 72 + m) * 2) = f2bf(val); } }
        }
    }
    LDS_BAR();
    asm volatile("" : "+v"(tid));
    f32x2v X2[32];
#pragma unroll
    for (int k = 0; k < 32; ++k) X2[k] = (f32x2v){0.f, 0.f};
#define X(i) (X2[(i) >> 1][(i) & 1])
    if (tid < 256) {
        unsigned srcoff = (tid < 128 ? M1_VS : M1_KS) + (tid & 127) * 2, facoff = tid < 128 ? M1_BETA : M1_BEG;
        asm volatile("" : "+v"(srcoff), "+v"(facoff));
        const LAS unsigned short* src = (const LAS unsigned short*)(lds + srcoff);
        const LAS float* fac = (const LAS float*)(lds + facoff);
        f32x4 cur[16];
        SolveRows<0>::run(X2, cur, lds, src, fac);
    } else {
        const int t2 = tid - 256; const float glc = GC[63];
#pragma unroll
        for (int it = 0; it < 4; ++it) {
            const int idx = t2 + 256 * it, frag = idx >> 6, l2 = idx & 63, tt = frag >> 2, ks = frag & 3, nn = l2 & 15, qq = l2 >> 4, c = 16 * tt + nn, dk0 = 32 * ks + 4 * qq;
            const u32x2 p0 = *(const LAS u32x2*)(lds + M1_QS + c * ROWB + dk0 * 2), p1 = *(const LAS u32x2*)(lds + M1_QS + c * ROWB + (dk0 + 16) * 2);
            const float f = QSCALE * EG[c];
            u32x4 o; o.x = pk_bf16(bflo(p0.x) * f, bfhi(p0.x) * f); o.y = pk_bf16(bflo(p0.y) * f, bfhi(p0.y) * f); o.z = pk_bf16(bflo(p1.x) * f, bfhi(p1.x) * f); o.w = pk_bf16(bflo(p1.y) * f, bfhi(p1.y) * f);
            *(u32x4*)(ub + 16384 + idx * 16) = o;
        }
#pragma unroll
        for (int it = 0; it < 4; ++it) {
            const int idx = t2 + 256 * it, frag = idx >> 6, l2 = idx & 63, t8 = frag >> 1, ks = frag & 1, nn = l2 & 15, qq = l2 >> 4, dk = 16 * t8 + nn;
            float v[8];
#pragma unroll
            for (int e = 0; e < 8; ++e) { const int tok = 32 * ks + 16 * (e >> 2) + 4 * qq + (e & 3); v[e] = bf2f(*(const LAS unsigned short*)(lds + M1_KS + tok * ROWB + dk * 2)) * __expf(glc - GC[tok]); }
            u32x4 o; o.x = pk_bf16(v[0], v[1]); o.y = pk_bf16(v[2], v[3]); o.z = pk_bf16(v[4], v[5]); o.w = pk_bf16(v[6], v[7]);
            *(u32x4*)(ub + 32768 + idx * 16) = o;
        }
#pragma unroll
        for (int it = 0; it < 2; ++it) {
            const int idx = t2 + 256 * it, frag = idx >> 6, l2 = idx & 63, tt = frag >> 1, ks = frag & 1, nn = l2 & 15, qq = l2 >> 4, c = 16 * tt + nn, m0 = 32 * ks + 4 * qq;
            const u32x2 p0 = *(const LAS u32x2*)(lds + M1_QKM + (c * 72 + m0) * 2), p1 = *(const LAS u32x2*)(lds + M1_QKM + (c * 72 + m0 + 16) * 2);
            u32x4 o; o.x = p0.x; o.y = p0.y; o.z = p1.x; o.w = p1.y;
            *(u32x4*)(ub + 49152 + idx * 16) = o;
        }
    }
    LDS_BAR();
    asm volatile("" : "+v"(tid));
    if (tid < 128) {
        const int sl = tid >> 4, nn = tid & 15; unsigned char* ubU = ub + 57344 + sl * 2048;
#pragma unroll
        for (int qq = 0; qq < 4; ++qq) {
            u32x4 o0, o1;
            o0.x = pk_bf16(X(4 * qq), X(4 * qq + 1)); o0.y = pk_bf16(X(4 * qq + 2), X(4 * qq + 3)); o0.z = pk_bf16(X(16 + 4 * qq), X(16 + 4 * qq + 1)); o0.w = pk_bf16(X(16 + 4 * qq + 2), X(16 + 4 * qq + 3));
            o1.x = pk_bf16(X(32 + 4 * qq), X(32 + 4 * qq + 1)); o1.y = pk_bf16(X(32 + 4 * qq + 2), X(32 + 4 * qq + 3)); o1.z = pk_bf16(X(48 + 4 * qq), X(48 + 4 * qq + 1)); o1.w = pk_bf16(X(48 + 4 * qq + 2), X(48 + 4 * qq + 3));
            u32x4* dst = (u32x4*)(ubU + (qq * 16 + nn) * 32); dst[0] = o0; dst[1] = o1;
        }
    } else if (tid < 256) {
        const int d = tid - 128;
#pragma unroll
        for (int c = 0; c < 64; ++c) *(LAS unsigned short*)(lds + M1_WS + c * ROWB + d * 2) = f2bf(X(c));
    } else if (tid == 256) glast[unit] = __expf(GC[63]);
    LDS_BAR();
    asm volatile("" : "+v"(tid));
#pragma unroll
    for (int it = 0; it < 2; ++it) {
        const int idx = tid + 512 * it, frag = idx >> 6, l2 = idx & 63, tt = frag >> 2, ks = frag & 3, nn = l2 & 15, qq = l2 >> 4, c = 16 * tt + nn, dk0 = 32 * ks + 4 * qq;
        const u32x2 p0 = *(const LAS u32x2*)(lds + M1_WS + c * ROWB + dk0 * 2), p1 = *(const LAS u32x2*)(lds + M1_WS + c * ROWB + (dk0 + 16) * 2);
        u32x4 o; o.x = p0.x; o.y = p0.y; o.z = p1.x; o.w = p1.y;
        *(u32x4*)(ub + idx * 16) = o;
    }
    LDS_BAR();
#undef X
}

constexpr int SC_BUF = 61440, SC_CTL = 131072;
#define MFMA16(a, b, c) __builtin_amdgcn_mfma_f32_16x16x32_bf16((a), (b), (c), 0, 0, 0)
__device__ __forceinline__ bf16x8 pack4(const f32x4& a, const f32x4& b) { u32x4 p; p.x = pk_bf16(a[0], a[1]); p.y = pk_bf16(a[2], a[3]); p.z = pk_bf16(b[0], b[1]); p.w = pk_bf16(b[2], b[3]); return __builtin_bit_cast(bf16x8, p); }
__device__ __forceinline__ const unsigned char* scan_piece(const unsigned char* ub, int half, int p) { return ub + (p < 56 ? p * 1024 : 57344 + half * 4096 + (p - 56) * 1024); }
__device__ __forceinline__ void scan_issue(LAS unsigned char* lds, const unsigned char* ub, int half, int buf, int wave, int lane) {
#pragma unroll
    for (int k = 0; k < 8; ++k) { const int p = wave + 8 * k;
        if (p < 60) __builtin_amdgcn_global_load_lds((const unsigned*)(scan_piece(ub, half, p) + lane * 16), (LAS unsigned*)(lds + buf * SC_BUF + p * 1024), 16, 0, 0); }
}
__device__ __forceinline__ void scan_prefetch(LAS unsigned char* lds, const unsigned char* ub, int half, int wave, int lane) {
#pragma unroll
    for (int k = 0; k < 2; ++k) { const int g8 = (wave - 4) * 2 + k;
        const unsigned char* src = ub + (g8 < 7 ? g8 * 8192 : 57344 + half * 4096) + lane * 128;
        __builtin_amdgcn_global_load_lds((const unsigned*)src, (LAS unsigned*)(lds + SC_CTL + 2048 + wave * 1024), 4, 0, 0); }
}
#define FRAG(off) (*(const LAS bf16x8*)(L + (off) + lane * 16))
__device__ __forceinline__ void scan_unit(LAS unsigned char* lds, int bh, int half, const unsigned char* inter, const float* glast, bf16* MIX, int tid) {
    const int wave = __builtin_amdgcn_readfirstlane(tid >> 6), lane = tid & 63, b = bh >> 2, h = bh & 3, nn = lane & 15, qq = lane >> 4;
    f32x4 S[8];
#pragma unroll
    for (int d = 0; d < 8; ++d) S[d] = (f32x4){0.f, 0.f, 0.f, 0.f};
    const int unit0 = (b * 128) * 4 + h;
    LAS float* GLS = (LAS float*)(lds + SC_CTL + 256);
    if (tid < 128) GLS[tid] = glast[unit0 + 4 * tid];
    scan_issue(lds, inter + (size_t)unit0 * UNIT_BYTES, half, 0, wave, lane);
    if (false) { scan_prefetch(lds, inter + (size_t)(unit0 + 4) * UNIT_BYTES, half, wave, lane); scan_prefetch(lds, inter + (size_t)(unit0 + 8) * UNIT_BYTES, half, wave, lane); scan_prefetch(lds, inter + (size_t)(unit0 + 12) * UNIT_BYTES, half, wave, lane); }
    asm volatile("s_waitcnt vmcnt(0)" ::: "memory"); __syncthreads();
#pragma unroll 1
    for (int n = 0; n < 128; ++n) {
        const int buf = n & 1, unit = unit0 + n * 4;
        if (n + 1 < 128) scan_issue(lds, inter + (size_t)(unit + 4) * UNIT_BYTES, half, buf ^ 1, wave, lane);
        const bool pf = false;
        if (pf) scan_prefetch(lds, inter + (size_t)(unit + 16) * UNIT_BYTES, half, wave, lane);
        if (wave < 2) {
            const LAS unsigned char* L = lds + buf * SC_BUF;
            const float gl = GLS[n];
#define SB() __builtin_amdgcn_sched_barrier(0)
            bf16x8 R1[16], R2[16];
#pragma unroll
            for (int t = 0; t < 4; ++t) { R1[2 * t] = FRAG((4 * t) * 1024); R1[2 * t + 1] = FRAG((4 * t + 1) * 1024); R1[8 + 2 * t] = FRAG(16384 + (4 * t) * 1024); R1[8 + 2 * t + 1] = FRAG(16384 + (4 * t + 1) * 1024); }
#pragma unroll
            for (int t = 0; t < 4; ++t) { R2[2 * t] = FRAG((4 * t + 2) * 1024); R2[2 * t + 1] = FRAG((4 * t + 3) * 1024); R2[8 + 2 * t] = FRAG(16384 + (4 * t + 2) * 1024); R2[8 + 2 * t + 1] = FRAG(16384 + (4 * t + 3) * 1024); }
            SB();
            bf16x8 Sb[4];
#pragma unroll
            for (int s = 0; s < 4; ++s) Sb[s] = pack4(S[2 * s], S[2 * s + 1]);
            f32x4 P[4], O[4];
#pragma unroll
            for (int t = 0; t < 4; ++t) { P[t] = (f32x4){0.f, 0.f, 0.f, 0.f}; O[t] = (f32x4){0.f, 0.f, 0.f, 0.f}; }
            SB();
#pragma unroll
            for (int s = 0; s < 2; ++s) {
#pragma unroll
                for (int t = 0; t < 4; ++t) P[t] = MFMA16(R1[2 * t + s], Sb[s], P[t]);
#pragma unroll
                for (int t = 0; t < 4; ++t) O[t] = MFMA16(Sb[s], R1[8 + 2 * t + s], O[t]);
                SB();
            }
#pragma unroll
            for (int d = 0; d < 8; ++d) R1[d] = FRAG(32768 + (2 * d) * 1024);
#pragma unroll
            for (int t = 0; t < 4; ++t) R1[8 + t] = FRAG(49152 + (t * 2) * 1024);
            R1[12] = FRAG(49152 + 5 * 1024); R1[13] = FRAG(49152 + 7 * 1024);
            const LAS u32x4* up = (const LAS u32x4*)(L + 57344 + wave * 2048 + lane * 32);
            const u32x4 u0 = up[0], u1 = up[1];
            SB();
#pragma unroll
            for (int s = 0; s < 2; ++s) {
#pragma unroll
                for (int t = 0; t < 4; ++t) P[t] = MFMA16(R2[2 * t + s], Sb[2 + s], P[t]);
#pragma unroll
                for (int t = 0; t < 4; ++t) O[t] = MFMA16(Sb[2 + s], R2[8 + 2 * t + s], O[t]);
                SB();
            }
#pragma unroll
            for (int d = 0; d < 8; ++d) R2[d] = FRAG(32768 + (2 * d + 1) * 1024);
            SB();
            P[0] = (f32x4){bflo(u0.x), bfhi(u0.x), bflo(u0.y), bfhi(u0.y)} - P[0]; P[1] = (f32x4){bflo(u0.z), bfhi(u0.z), bflo(u0.w), bfhi(u0.w)} - P[1];
            P[2] = (f32x4){bflo(u1.x), bfhi(u1.x), bflo(u1.y), bfhi(u1.y)} - P[2]; P[3] = (f32x4){bflo(u1.z), bfhi(u1.z), bflo(u1.w), bfhi(u1.w)} - P[3];
            bf16x8 Vb[2]; Vb[0] = pack4(P[0], P[1]); Vb[1] = pack4(P[2], P[3]);
#pragma unroll
            for (int d = 0; d < 8; ++d) S[d] = S[d] * gl;
            SB();
#pragma unroll
            for (int d = 0; d < 8; ++d) S[d] = MFMA16(R1[d], Vb[0], S[d]);
#pragma unroll
            for (int t = 0; t < 4; ++t) O[t] = MFMA16(Vb[0], R1[8 + t], O[t]);
            SB();
#pragma unroll
            for (int d = 0; d < 8; ++d) S[d] = MFMA16(R2[d], Vb[1], S[d]);
            O[2] = MFMA16(Vb[1], R1[12], O[2]); O[3] = MFMA16(Vb[1], R1[13], O[3]);
            SB();
            bf16* orow = MIX + ((size_t)b * TSEQ + n * 64 + nn) * 1024 + h * 128 + (half * 2 + wave) * 16 + 4 * qq;
#pragma unroll
            for (int t = 0; t < 4; ++t) { u32x2 o; o.x = pk_bf16(O[t][0], O[t][1]); o.y = pk_bf16(O[t][2], O[t][3]); *(__attribute__((address_space(1))) u32x2*)(orow + (size_t)t * 16 * 1024) = o; }
#undef SB
        }
        if (wave < 2) asm volatile("s_waitcnt vmcnt(4) lgkmcnt(0)" ::: "memory");
        else if (pf) asm volatile("s_waitcnt vmcnt(2) lgkmcnt(0)" ::: "memory");
        else asm volatile("s_waitcnt vmcnt(0) lgkmcnt(0)" ::: "memory");
        __builtin_amdgcn_s_barrier(); asm volatile("" ::: "memory");
    }
    asm volatile("s_waitcnt vmcnt(0) lgkmcnt(0)" ::: "memory"); __syncthreads();
}
#undef FRAG

__device__ __forceinline__ void sc_chunk(int chunk, const bf16* PS, const float* scw, const float* scg, bf16* MIX, int tid) {
    const int wave = tid >> 6, lane = tid & 63, tq = lane >> 4, jj = lane & 15;
#pragma unroll 1
    for (int it = 0; it < 8; ++it) {
        const int wi = wave * 8 + it, quad = wi >> 2, grp = wi & 3;
        const int token = chunk * 64 + quad * 4 + tq, tin = token & (TSEQ - 1), ch = grp * 128 + 8 * jj;
        const bf16* base = PS + (size_t)token * 1536 + ch;
        const u32x4 Bv = *(const u32x4*)base;
        float cv[8];
#pragma unroll
        for (int e = 0; e < 8; ++e) cv[e] = 0.f;
#pragma unroll
        for (int d = 0; d < 3; ++d) {
            if (tin - d >= 0) {
                const u32x4 Cv = *(const u32x4*)(base - (size_t)d * 1536 + 512), Hv = *(const u32x4*)(base - (size_t)d * 1536 + 1024);
                const float* wp = scw + (2 - d) * 512 + ch; const f32x4 w0 = *(const f32x4*)wp, w1 = *(const f32x4*)(wp + 4);
                cv[0] += w0.x * (bflo(Cv.x) * bflo(Hv.x)); cv[1] += w0.y * (bfhi(Cv.x) * bfhi(Hv.x)); cv[2] += w0.z * (bflo(Cv.y) * bflo(Hv.y)); cv[3] += w0.w * (bfhi(Cv.y) * bfhi(Hv.y));
                cv[4] += w1.x * (bflo(Cv.z) * bflo(Hv.z)); cv[5] += w1.y * (bfhi(Cv.z) * bfhi(Hv.z)); cv[6] += w1.z * (bflo(Cv.w) * bflo(Hv.w)); cv[7] += w1.w * (bfhi(Cv.w) * bfhi(Hv.w));
            }
        }
        float y[8] = {bflo(Bv.x) * cv[0], bfhi(Bv.x) * cv[1], bflo(Bv.y) * cv[2], bfhi(Bv.y) * cv[3], bflo(Bv.z) * cv[4], bfhi(Bv.z) * cv[5], bflo(Bv.w) * cv[6], bfhi(Bv.w) * cv[7]};
        float ssq = 0.f;
#pragma unroll
        for (int e = 0; e < 8; ++e) ssq += y[e] * y[e];
        ssq = sum16(ssq);
        const float rn = rsqrtf(ssq * (1.0f / 128.0f) + 1e-6f);
        const f32x4 g0 = *(const f32x4*)(scg + ch), g1 = *(const f32x4*)(scg + ch + 4);
        u32x4 o; o.x = pk_bf16(y[0] * rn * g0.x, y[1] * rn * g0.y); o.y = pk_bf16(y[2] * rn * g0.z, y[3] * rn * g0.w); o.z = pk_bf16(y[4] * rn * g1.x, y[5] * rn * g1.y); o.w = pk_bf16(y[6] * rn * g1.z, y[7] * rn * g1.w);
        *(u32x4*)(MIX + (size_t)token * 1024 + 512 + ch) = o;
    }
}

#define XB_TMO      128
#define XB_XCNT(j)  (256  + 64 * (j))
#define XB_XSUB(j)  (1280 + 64 * (j))
#define XB_XGEN(j)  (2304 + 64 * (j))
#define XB_TOP      3328
#define XB_TOPGEN   3392
#define XCD_BAR_WORDS 3456
#define XB_SPIN_CAP (1u << 18)

__device__ __forceinline__ unsigned xb_ld(unsigned* p)              { return __hip_atomic_load(p, __ATOMIC_RELAXED, __HIP_MEMORY_SCOPE_AGENT); }
__device__ __forceinline__ unsigned xb_add(unsigned* p, unsigned v) { return __hip_atomic_fetch_add(p, v, __ATOMIC_RELAXED, __HIP_MEMORY_SCOPE_AGENT); }
__device__ __forceinline__ unsigned xb_xcc_id() { return (unsigned)__builtin_amdgcn_s_getreg((3 << 11) | 20) & 0xFu; }
#define XB_SPIN(cond, bar) do { unsigned _sp = 0; while (cond) { __builtin_amdgcn_s_sleep(1); \
    if ((++_sp & 255u) == 0u) { if (xb_ld(&(bar)[XB_TMO])) break; if (_sp > XB_SPIN_CAP) { atomicAdd(&(bar)[XB_TMO], 1u); break; } } } } while (0)

struct XcdBarrier {
    unsigned* bar; unsigned x;
    volatile LAS unsigned* st;
};

__device__ __forceinline__ XcdBarrier xcd_barrier_post(unsigned* bar, volatile LAS unsigned* st) {
    XcdBarrier b; b.bar = bar; b.x = xb_xcc_id(); b.st = st;
    if (threadIdx.x == 0) (void)xb_add(&bar[XB_XCNT(b.x)], 1u);
    return b;
}
__device__ __forceinline__ void xcd_barrier_complete(unsigned* bar, unsigned x, unsigned& nloc, unsigned& nx) {
    const unsigned G = gridDim.x * gridDim.y * gridDim.z;
    unsigned sum, cnt, mine, sp = 0u;
    for (;;) {
        sum = 0u; cnt = 0u; mine = 0u;
#pragma unroll
        for (unsigned j = 0; j < 16; ++j) { const unsigned c = xb_ld(&bar[XB_XCNT(j)]); sum += c; cnt += (c > 0u) ? 1u : 0u; mine = (j == x) ? c : mine; }
        if (sum == G) break;
        __builtin_amdgcn_s_sleep(1);
        if ((++sp & 255u) == 0u) { if (xb_ld(&bar[XB_TMO])) break; if (sp > XB_SPIN_CAP) { atomicAdd(&bar[XB_TMO], 1u); break; } }
    }
    nloc = mine > 0u ? mine : 1u; nx = cnt > 0u ? cnt : 1u;
}

__device__ __forceinline__ void xcd_barrier(const XcdBarrier& b) {
    asm volatile("s_waitcnt vmcnt(0)" ::: "memory");
    __syncthreads();
    if (threadIdx.x == 0) {
        unsigned* bar = b.bar;
        __builtin_amdgcn_s_waitcnt(0);
        unsigned nloc = b.st[0], nx = b.st[1];
        if (nloc == 0u) { xcd_barrier_complete(bar, b.x, nloc, nx); b.st[0] = nloc; b.st[1] = nx; }
        const unsigned old = xb_add(&bar[XB_XSUB(b.x)], 1u);
        const unsigned gen = old / nloc;
        if (old + 1u == (gen + 1u) * nloc) {
            __builtin_amdgcn_fence(__ATOMIC_RELEASE, "agent");
            asm volatile("s_waitcnt vmcnt(0)" ::: "memory");
            const unsigned og = xb_add(&bar[XB_TOP], 1u);
            const unsigned tg = og / nx;
            if (og + 1u == (tg + 1u) * nx) xb_add(&bar[XB_TOPGEN], 1u);
            else XB_SPIN(xb_ld(&bar[XB_TOPGEN]) == tg, bar);
            __builtin_amdgcn_fence(__ATOMIC_ACQUIRE, "agent");
            xb_add(&bar[XB_XGEN(b.x)], 1u);
            asm volatile("s_waitcnt vmcnt(0)" ::: "memory");
        } else {
            XB_SPIN(xb_ld(&bar[XB_XGEN(b.x)]) == gen, bar);
            __builtin_amdgcn_fence(__ATOMIC_ACQUIRE, "agent");
            asm volatile("s_waitcnt vmcnt(0)" ::: "memory");
        }
    }
    __syncthreads();
}

#define GRID_BAR() do { XcdBarrier _b; _b.bar = (unsigned*)(launder_p(a.ws) + WS_CTL + 4096); _b.x = xb_xcc_id(); _b.st = (volatile LAS unsigned*)(lds + 131072 + 1024); xcd_barrier(_b); } while (0)
__global__ void __launch_bounds__(512, 2) hybrid_fwd(Args a) {
    extern __shared__ __attribute__((aligned(16))) unsigned char lds_raw[];
    LAS unsigned char* lds = (LAS unsigned char*)lds_raw;
    cg::grid_group grid = cg::this_grid();
    const int tid0 = threadIdx.x;
    if (tid0 < 8) ((LAS unsigned*)(lds + 131072 + 1024))[tid0] = 0u;
    __syncthreads();
    grid.sync();
    (void)xcd_barrier_post((unsigned*)(launder_p(a.ws) + WS_CTL + 4096), (volatile LAS unsigned*)(lds + 131072 + 1024));
    const int wave_s = __builtin_amdgcn_readfirstlane(threadIdx.x >> 6), bx = blockIdx.x, G = gridDim.x;
#define tid fresh_tid(wave_s)
    p0_prologue(a, lds, G, bx, tid);
    GRID_BAR();

#pragma unroll 1
    for (int l = 0; l < NLAYER; ++l) {
#define WSP(off) (launder_p(a.ws) + (off))
        {
            unsigned char* w = launder_p(a.ws);
            pg8::Gemm g{(const bf16*)(w + WS_XB), (const bf16*)(w + WS_W + (size_t)l * LW + LW_IN), MTOK, NIN, DM}; pg8::StaticOrder S; S.init(MTOK, NIN, G, bx);
            pg8::EpiInProj E{(bf16*)(w + WS_PA), (bf16*)(w + WS_PZ), (bf16*)(w + WS_PS), (float*)(w + WS_BG), (const float*)(w + WS_SSP1), INP(4) + l * 4, INP(5) + l * 4};
            for (int rep = 0; rep < PROBE_G1; ++rep)
            pg8::gemm_phase<pg8::EpiInProj, pg8::StaticOrder, true, true>(lds, g, S, E, tid);
        }
        GRID_BAR();
        {
            unsigned char* w = launder_p(a.ws);
            const float* cwp = INP(3) + (size_t)l * 4 * 1536;
            {
                const int t3 = launder_v(tid);
                for (int i = t3; i < 4 * 4 * 384; i += 512) { const int hh = i / 1536, r2 = i % 1536, tap = r2 / 384, c2 = r2 % 384, s2 = c2 >> 7, ch = c2 & 127;
                    ((LAS float*)(lds + M1_CW))[i] = cwp[tap * 1536 + s2 * 512 + hh * 128 + ch]; }
                __syncthreads();
            }
            for (int rep = 0; rep < PROBE_M1; ++rep)
            for (int u = bx; u < 4096; u += G) m1_unit(lds, u, (const bf16*)(w + WS_PA), (const float*)(w + WS_BG), cwp, w + WS_INTER, (float*)(w + WS_SS), tid);
        }
        GRID_BAR();
        for (int rep = 0; rep < PROBE_SCAN; ++rep)
        for (int su = bx; su < 128; su += G) { unsigned char* w = launder_p(a.ws); const int xcd = su & 7, kk = su >> 3; scan_unit(lds, xcd * 4 + (kk >> 2), kk & 3, w + WS_INTER, (const float*)(w + WS_SS), (bf16*)(w + WS_MIX), launder_v(tid)); }
        {
            LAS unsigned* sh = (LAS unsigned*)(lds + 131072);
            unsigned char* w = launder_p(a.ws); unsigned* ctl = (unsigned*)(w + WS_CTL); const bf16* PS = (const bf16*)(w + WS_PS); bf16* MIX = (bf16*)(w + WS_MIX);
            const float* scw = INP(7) + (size_t)l * 3 * 512; const float* scg = INP(8) + (size_t)l * 512;
            for (;;) {
                if (tid == 0) sh[0] = atomicAdd(ctl + 64 * l, 1u);
                LDS_BAR();
                const unsigned c = sh[0];
                LDS_BAR();
                if (c >= 1024u) break;
                sc_chunk((int)c, PS, scw, scg, MIX, launder_v(tid));
            }
        }
        GRID_BAR();
        {
            unsigned char* w = launder_p(a.ws); bf16* MIX = (bf16*)(w + WS_MIX); const bf16* PZ = (const bf16*)(w + WS_PZ);
            const int tid5 = launder_v(tid), G5 = launder_i(G); const float* gn = INP(6) + l * 128; const int jj = tid5 & 15; const f32x4 g0 = *(const f32x4*)(gn + 8 * jj), g1 = *(const f32x4*)(gn + 8 * jj + 4);
            const int istride = (G5 * 512) >> 4;
#pragma unroll 1
            for (int item0 = (bx * 512 + tid5) >> 4; item0 < MTOK * 4; item0 += 4 * istride) {
                u32x4 ov[4], zv[4];
#pragma unroll
                for (int q = 0; q < 4; ++q) { const int item = item0 + q * istride, it2 = item < MTOK * 4 ? item : item0, token = it2 >> 2, hd = it2 & 3;
                    ov[q] = *(const u32x4*)(MIX + (size_t)token * 1024 + hd * 128 + 8 * jj); zv[q] = *(const u32x4*)(PZ + (size_t)token * 512 + hd * 128 + 8 * jj); }
#pragma unroll
                for (int q = 0; q < 4; ++q) { const int item = item0 + q * istride; if (item < MTOK * 4) { const int token = item >> 2, hd = item & 3;
                    float o[8] = {bflo(ov[q].x), bfhi(ov[q].x), bflo(ov[q].y), bfhi(ov[q].y), bflo(ov[q].z), bfhi(ov[q].z), bflo(ov[q].w), bfhi(ov[q].w)};
                    float z[8] = {bflo(zv[q].x), bfhi(zv[q].x), bflo(zv[q].y), bfhi(zv[q].y), bflo(zv[q].z), bfhi(zv[q].z), bflo(zv[q].w), bfhi(zv[q].w)};
                    float ssq = 0.f;
#pragma unroll
                    for (int e = 0; e < 8; ++e) ssq += o[e] * o[e];
                    ssq = sum16(ssq);
                    const float rn = rsqrtf(ssq * (1.0f / 128.0f) + 1e-6f);
                    const float gg[8] = {g0.x, g0.y, g0.z, g0.w, g1.x, g1.y, g1.z, g1.w};
#pragma unroll
                    for (int e = 0; e < 8; ++e) o[e] = o[e] * rn * gg[e] * (z[e] * __builtin_amdgcn_rcpf(1.0f + __expf(-z[e])));
                    u32x4 w; w.x = pk_bf16(o[0], o[1]); w.y = pk_bf16(o[2], o[3]); w.z = pk_bf16(o[4], o[5]); w.w = pk_bf16(o[6], o[7]);
                    *(u32x4*)(MIX + (size_t)token * 1024 + hd * 128 + 8 * jj) = w; } }
            }
        }
        GRID_BAR();
        {
            unsigned char* w = launder_p(a.ws);
            pg8::Gemm g{(const bf16*)(w + WS_MIX), (const bf16*)(w + WS_W + (size_t)l * LW + LW_OUT), MTOK, DM, DM}; pg8::StaticOrder S; S.init(MTOK, DM, G, bx);
            pg8::EpiResid E{(bf16*)(w + WS_XB), (float*)(w + WS_SSP2)};
            pg8::gemm_phase<pg8::EpiResid, pg8::StaticOrder, true, true>(lds, g, S, E, tid);
        }
        GRID_BAR();
        {
            unsigned char* w = launder_p(a.ws);
            pg8::Gemm g{(const bf16*)(w + WS_XB), (const bf16*)(w + WS_W + (size_t)l * LW + LW_GU), MTOK, NGU, DM}; pg8::StaticOrder S; S.init(MTOK, NGU, G, bx);
            pg8::EpiSwiGLU E{(bf16*)(w + WS_ACT), (const float*)(w + WS_SSP2)};
            for (int rep = 0; rep < PROBE_G3; ++rep)
            pg8::gemm_phase<pg8::EpiSwiGLU, pg8::StaticOrder, true, true>(lds, g, S, E, tid);
        }
        GRID_BAR();
        {
            unsigned char* w = launder_p(a.ws);
            pg8::Gemm g{(const bf16*)(w + WS_ACT), (const bf16*)(w + WS_W + (size_t)l * LW + LW_DN), MTOK, DM, FF}; pg8::StaticOrder S; S.init(MTOK, DM, G, bx);
            pg8::EpiResid E{(bf16*)(w + WS_XB), (float*)(w + WS_SSP1)};
            pg8::gemm_phase<pg8::EpiResid, pg8::StaticOrder, true, true>(lds, g, S, E, tid);
        }
        GRID_BAR();
    }
    {
        unsigned char* w = launder_p(a.ws); float* X = (float*)launder_p((unsigned char*)a.out); const float* SS1 = (const float*)(w + WS_SSP1);
        const int tidf = launder_v(tid), lane = tidf & 63;
        const float* gf = INP(14); const int gw = bx * 8 + (tidf >> 6), NGW = G * 8;
        f32x4 gv[4];
#pragma unroll
        for (int j = 0; j < 4; ++j) gv[j] = ((const f32x4*)gf)[lane + 64 * j];
        const bf16* XBf = (const bf16*)(w + WS_XB);
        for (int m = gw; m < MTOK; m += 2 * NGW) {
            const int m2 = m + NGW < MTOK ? m + NGW : m;
            const u32x2* xbr = (const u32x2*)(XBf + (size_t)m * DM) + lane; const u32x2* xbr2 = (const u32x2*)(XBf + (size_t)m2 * DM) + lane;
            u32x2 p[4], p2[4];
#pragma unroll
            for (int j = 0; j < 4; ++j) { p[j] = xbr[64 * j]; p2[j] = xbr2[64 * j]; }
            const float rn = pg8::row_rs(SS1, m), rn2 = pg8::row_rs(SS1, m2);
            f32x4* xr = (f32x4*)(X + (size_t)m * DM) + lane; f32x4* xr2 = (f32x4*)(X + (size_t)m2 * DM) + lane;
#pragma unroll
            for (int j = 0; j < 4; ++j) { f32x4 v = {bflo(p[j].x), bfhi(p[j].x), bflo(p[j].y), bfhi(p[j].y)}; v = v * rn * gv[j]; xr[64 * j] = v; }
            if (m2 != m) {
#pragma unroll
                for (int j = 0; j < 4; ++j) { f32x4 v = {bflo(p2[j].x), bfhi(p2[j].x), bflo(p2[j].y), bfhi(p2[j].y)}; v = v * rn2 * gv[j]; xr2[64 * j] = v; }
            }
        }
    }
}

extern "C" void kernel_launch(void* const* d_in, const int* in_sizes, int n_in, void* d_out, int out_size, void* d_ws, size_t ws_size, hipStream_t stream) {
    static int grid_blocks = 0;
    if (grid_blocks == 0) {
        if (n_in != 15 || in_sizes[0] != MTOK * DM || out_size != MTOK * DM || ws_size < WS_END) { fprintf(stderr, "kernel_launch: unexpected shapes (n_in %d, in0 %d, out %d, ws %zu)\n", n_in, n_in > 0 ? in_sizes[0] : -1, out_size, ws_size); grid_blocks = -1; return; }
        int dev = 0, cus = 0, per_cu = 0;
        hipGetDevice(&dev); hipDeviceGetAttribute(&cus, hipDeviceAttributeMultiprocessorCount, dev);
        if (hipFuncSetAttribute((const void*)hybrid_fwd, hipFuncAttributeMaxDynamicSharedMemorySize, LDS_BYTES) != hipSuccess) { fprintf(stderr, "kernel_launch: hipFuncSetAttribute failed\n"); grid_blocks = -1; return; }
        if (hipOccupancyMaxActiveBlocksPerMultiprocessor(&per_cu, (const void*)hybrid_fwd, 512, LDS_BYTES) != hipSuccess || per_cu < 1) { fprintf(stderr, "kernel_launch: occupancy query gave %d\n", per_cu); per_cu = 1; }
        (void)hipGetLastError();
        grid_blocks = cus * 1;
        fprintf(stderr, "kernel_launch: cus %d per_cu %d grid %d\n", cus, per_cu, grid_blocks);
    }
    if (grid_blocks < 0) return;
    hipMemsetAsync((char*)d_ws + WS_CTL, 0, 4096 + 16384, stream);
    Args a{};
    for (int i = 0; i < 15; ++i) a.in[i] = (const float*)d_in[i];
    a.out = (float*)d_out; a.ws = (unsigned char*)d_ws;
    void* args[] = {&a};
    hipError_t e = hipLaunchCooperativeKernel((const void*)hybrid_fwd, dim3(grid_blocks), dim3(512), args, LDS_BYTES, stream);
    if (e != hipSuccess) fprintf(stderr, "cooperative launch failed: %s (grid %d)\n", hipGetErrorString(e), grid_blocks);
}
```

```cpp
#include <hip/hip_runtime.h>
#include <hip/hip_cooperative_groups.h>
#include <cstdio>
#include <cstdint>
namespace cg = cooperative_groups;
namespace pg8 {
#define PG8_LAS __attribute__((address_space(3)))
typedef unsigned short bf16_t;
typedef short bf16x8 __attribute__((ext_vector_type(8)));
typedef float f32x4 __attribute__((ext_vector_type(4)));
typedef unsigned u32x4 __attribute__((ext_vector_type(4)));
constexpr int BM = 256, BK = 64, HALF = 128, HTB = HALF * BK * 2  , STAGE_BYTES = 8 * HTB, NXCD = 8, WGM = 8;

__host__ __device__ __forceinline__ int lds_byte(int r, int c) { const int st = (r >> 4) * 2 + (c >> 5), rr = r & 15, cc = c & 31, ob = rr * 64 + cc * 2; return st * 1024 + (ob ^ (((ob >> 9) & 1) << 5)); }
__host__ __device__ __forceinline__ void stage_rc(int b, int& R, int& C) { const int st = b / 1024, sb = b % 1024, swz = sb ^ (((sb >> 9) & 1) << 5); R = (st >> 1) * 16 + swz / 64; C = (st & 1) * 32 + (swz % 64) / 2; }
__host__ __device__ __forceinline__ int perm32(int rho) { const int n = rho >> 4, i = rho & 15; return 8 * (i >> 2) + 4 * n + (i & 3); }

struct Unit { int pm, pn; };
struct Gemm { const bf16_t* A; const bf16_t* Bt; int M, N, K; };

struct StaticOrder {
    int nM, nN, nwg, G, c;
    __host__ __device__ void init(int M, int N, int G_, int c_) { nM = M / BM; nN = N / BM; nwg = nM * nN; G = G_; c = c_; }
    __host__ __device__ bool next(int i, Unit& u) const {
        const long L = (long)i * G + c; if (L >= nwg) return false;
        int wgid = (int)L; { const int q = nwg / NXCD, r = nwg % NXCD, xcd = wgid % NXCD, off = wgid / NXCD; wgid = (xcd < r ? xcd * (q + 1) : r * (q + 1) + (xcd - r) * q) + off; }
        const int nig = WGM * nN, gid = wgid / nig, fm = gid * WGM, gsz = (nM - fm) < WGM ? (nM - fm) : WGM;
        u.pm = fm + ((wgid % nig) % gsz); u.pn = (wgid % nig) / gsz; return true;
    }
    __device__ __forceinline__ void a_ready(const Unit&) const {}
    __device__ __forceinline__ void done(const Unit&) const {}
};

typedef float f32x2 __attribute__((ext_vector_type(2)));
typedef __bf16 bf16x2_t __attribute__((ext_vector_type(2)));
__device__ __forceinline__ unsigned pk_bf16(float lo, float hi) { f32x2 v = {lo, hi}; bf16x2_t b = __builtin_convertvector(v, bf16x2_t); return __builtin_bit_cast(unsigned, b); }
__device__ __forceinline__ float sigmoid_f(float x) { return __builtin_amdgcn_rcpf(1.0f + __expf(-x)); }
__device__ __forceinline__ float row_rs(const float* ssp, int row) {
    const f32x4* p = (const f32x4*)(ssp + (size_t)row * 16); const f32x4 a = p[0], b = p[1], c = p[2], d = p[3];
    const float s = (((a.x + a.y) + (a.z + a.w)) + ((b.x + b.y) + (b.z + b.w))) + (((c.x + c.y) + (c.z + c.w)) + ((d.x + d.y) + (d.z + d.w)));
    return rsqrtf(s * (1.0f / 1024.0f) + 1e-6f);
}

__device__ __forceinline__ void row_rs8(const float* ssp, int row0, int fq, float (&rr)[8]) {
    f32x4 pv[8];
#pragma unroll
    for (int k = 0; k < 8; ++k) pv[k] = *(const __attribute__((address_space(1))) f32x4*)(ssp + (size_t)(row0 + (k >> 2) * HALF + (k & 3) * 16) * 16 + 4 * fq);
#pragma unroll
    for (int k = 0; k < 8; ++k) { float s = (pv[k].x + pv[k].y) + (pv[k].z + pv[k].w); s += __shfl_xor(s, 16); s += __shfl_xor(s, 32); rr[k] = rsqrtf(s * (1.0f / 1024.0f) + 1e-6f); }
}

struct EpiInProj {
    static constexpr bool PERM = true, AFTER_DRAIN = false;
    bf16_t* PA; bf16_t* PZ; bf16_t* PS; float* BG; const float* ss; const float* a_log; const float* dt_bias;
    __device__ __forceinline__ void operator()(const f32x4 (&acc)[2][2][4][2], const Unit& u, int wr, int wc, int fr, int fq) const {
        const int row0 = u.pm * BM + wr * 64 + fr;
        float rr[8]; row_rs8(ss, row0, fq, rr);
        if (u.pn < 14) {
            bf16_t* base; int ldc, colt;
            if (u.pn < 6) { base = PA; ldc = 1536; colt = u.pn * 256; }
            else if (u.pn < 8) { base = PZ; ldc = 512; colt = (u.pn - 6) * 256; }
            else { base = PS; ldc = 1536; colt = (u.pn - 8) * 256; }
            const int col0 = colt + wc * 32 + 8 * fq;
#pragma unroll
            for (int ai = 0; ai < 2; ++ai)
#pragma unroll
                for (int m = 0; m < 4; ++m) {
                    const int row = row0 + ai * HALF + m * 16;
                    const float r = rr[ai * 4 + m];
                    bf16_t* rowp = base + (size_t)row * ldc + col0;
#pragma unroll
                    for (int bj = 0; bj < 2; ++bj) {
                        const f32x4 v0 = acc[ai][bj][m][0] * r, v1 = acc[ai][bj][m][1] * r;
                        u32x4 w; w.x = pk_bf16(v0[0], v0[1]); w.y = pk_bf16(v0[2], v0[3]); w.z = pk_bf16(v1[0], v1[1]); w.w = pk_bf16(v1[2], v1[3]);
                        *(__attribute__((address_space(1))) u32x4*)(rowp + bj * HALF) = w;
                    }
                }
        } else if (wc == 0) {
            if (fq == 0) {
                const f32x4 al = *(const f32x4*)a_log, db = *(const f32x4*)dt_bias;
                const f32x4 ea = {__expf(al[0]), __expf(al[1]), __expf(al[2]), __expf(al[3])};
#pragma unroll
                for (int ai = 0; ai < 2; ++ai)
#pragma unroll
                    for (int m = 0; m < 4; ++m) {
                        const int row = row0 + ai * HALF + m * 16;
                        const float r = rr[ai * 4 + m];
                        const f32x4 bi = acc[ai][0][m][0] * r, av = acc[ai][0][m][1] * r;
                        f32x4 be, gg;
#pragma unroll
                        for (int h = 0; h < 4; ++h) {
                            be[h] = __builtin_amdgcn_rcpf(1.0f + __expf(-bi[h]));
                            const float xx = av[h] + db[h], ee = __expf(xx);
                            const float sp = xx > 20.f ? xx : (ee < 0.03f ? ee * (1.0f - ee * (0.5f - ee * (0.33333334f - 0.25f * ee))) : __logf(1.0f + ee));
                            gg[h] = -ea[h] * sp;
                        }
                        *(__attribute__((address_space(1))) f32x4*)(BG + (size_t)row * 8) = be; *(__attribute__((address_space(1))) f32x4*)(BG + (size_t)row * 8 + 4) = gg;
                    }
            }
        }
    }
};

struct EpiResid {
    static constexpr bool PERM = true, AFTER_DRAIN = false;
    bf16_t* xb; float* ss;
    __device__ __forceinline__ void operator()(const f32x4 (&acc)[2][2][4][2], const Unit& u, int wr, int wc, int fr, int fq) const {
        const int row0 = u.pm * BM + wr * 64 + fr, col0 = u.pn * BM + wc * 32 + 8 * fq;
        u32x4 xin[8][2];
#pragma unroll
        for (int k = 0; k < 8; ++k)
#pragma unroll
            for (int bj = 0; bj < 2; ++bj) xin[k][bj] = *(const __attribute__((address_space(1))) u32x4*)(xb + (size_t)(row0 + (k >> 2) * HALF + (k & 3) * 16) * 1024 + col0 + bj * HALF);
#pragma unroll
        for (int ai = 0; ai < 2; ++ai)
#pragma unroll
            for (int m = 0; m < 4; ++m) {
                const int row = row0 + ai * HALF + m * 16; const size_t off = (size_t)row * 1024 + col0;
                float sq = 0.f;
#pragma unroll
                for (int bj = 0; bj < 2; ++bj) {
                    const u32x4 xv = xin[ai * 4 + m][bj];
                    const f32x4 a0 = acc[ai][bj][m][0], a1 = acc[ai][bj][m][1];
                    u32x4 w;
                    w.x = pk_bf16(__uint_as_float(xv.x << 16) + a0[0], __uint_as_float(xv.x & 0xffff0000u) + a0[1]);
                    w.y = pk_bf16(__uint_as_float(xv.y << 16) + a0[2], __uint_as_float(xv.y & 0xffff0000u) + a0[3]);
                    w.z = pk_bf16(__uint_as_float(xv.z << 16) + a1[0], __uint_as_float(xv.z & 0xffff0000u) + a1[1]);
                    w.w = pk_bf16(__uint_as_float(xv.w << 16) + a1[2], __uint_as_float(xv.w & 0xffff0000u) + a1[3]);
                    *(__attribute__((address_space(1))) u32x4*)(xb + off + bj * HALF) = w;
                    const float r0 = __uint_as_float(w.x << 16), r1 = __uint_as_float(w.x & 0xffff0000u), r2 = __uint_as_float(w.y << 16), r3 = __uint_as_float(w.y & 0xffff0000u);
                    const float r4 = __uint_as_float(w.z << 16), r5 = __uint_as_float(w.z & 0xffff0000u), r6 = __uint_as_float(w.w << 16), r7 = __uint_as_float(w.w & 0xffff0000u);
                    sq += ((r0 * r0 + r1 * r1) + (r2 * r2 + r3 * r3)) + ((r4 * r4 + r5 * r5) + (r6 * r6 + r7 * r7));
                }
                sq += __shfl_xor(sq, 16); sq += __shfl_xor(sq, 32);
                if (fq == 0) *(__attribute__((address_space(1))) float*)(ss + (size_t)row * 16 + u.pn * 4 + wc) = sq;
                asm volatile("" ::: "memory");
            }
    }
};

struct EpiSwiGLU {
    static constexpr bool PERM = true, AFTER_DRAIN = false;
    bf16_t* act; const float* ss;
    __device__ __forceinline__ void operator()(const f32x4 (&acc)[2][2][4][2], const Unit& u, int wr, int wc, int fr, int fq) const {
        const int row0 = u.pm * BM + wr * 64 + fr, col0 = u.pn * HALF + wc * 32 + 8 * fq;
        float rr[8]; row_rs8(ss, row0, fq, rr);
#pragma unroll
        for (int ai = 0; ai < 2; ++ai)
#pragma unroll
            for (int m = 0; m < 4; ++m) {
                const int row = row0 + ai * HALF + m * 16;
                const float r = rr[ai * 4 + m];
                float o[8];
#pragma unroll
                for (int n = 0; n < 2; ++n)
#pragma unroll
                    for (int j = 0; j < 4; ++j) { const float g = acc[ai][0][m][n][j] * r, up = acc[ai][1][m][n][j] * r; o[n * 4 + j] = g * sigmoid_f(g) * up; }
                u32x4 w; w.x = pk_bf16(o[0], o[1]); w.y = pk_bf16(o[2], o[3]); w.z = pk_bf16(o[4], o[5]); w.w = pk_bf16(o[6], o[7]);
                *(__attribute__((address_space(1))) u32x4*)(act + (size_t)row * 2816 + col0) = w;
            }
    }
};

template <class Epi, class Sched, bool ALIGN_EPI = false, bool SP2 = false>
__device__ __forceinline__ void gemm_phase(PG8_LAS unsigned char* lds, const Gemm g, const Sched& S, const Epi& E, int tid_arg) {
    int tid_l = tid_arg; asm volatile("" : "+v"(tid_l));
    const int tid = tid_l, wid = __builtin_amdgcn_readfirstlane(tid >> 6), lane = tid & 63, wr = wid >> 2, wc = wid & 3, fr = lane & 15, fq = lane >> 4;
    const int K = g.K, nt = K / BK;
    unsigned voffA[2], voffB[2];
#pragma unroll
    for (int i = 0; i < 2; ++i) { int R, C; stage_rc(tid * 16 + i * 8192, R, C); const int Rb = Epi::PERM ? ((R & ~31) + perm32(R & 31)) : R;
        voffA[i] = (unsigned)(R * K + C) * 2u; voffB[i] = (unsigned)(Rb * K + C) * 2u; }
    const size_t kstep = (size_t)(BK * 2);
    const size_t hstep = (size_t)HALF * K * 2;
    const size_t tstep = 2 * hstep;
    const unsigned ldsw = (unsigned)wid * 1024u;
    const int aoff = lds_byte(wr * 64 + fr, fq * 8), boff = lds_byte(wc * 32 + fr, fq * 8);
#define PG8_SA(b, h) (((b) * 2 + (h)) * HTB)
#define PG8_SB(b, h) ((4 + (b) * 2 + (h)) * HTB)
#define PG8_STAGE(bufoff, gbase, voff) do { _Pragma("unroll") for (int _i = 0; _i < 2; ++_i) \
        __builtin_amdgcn_global_load_lds((const unsigned*)((const char*)(gbase) + (voff)[_i]), (PG8_LAS unsigned*)(lds + (bufoff) + ldsw + _i * 8192), 16, 0, 0); } while (0)
#define PG8_LDA(dst, b, h) do { _Pragma("unroll") for (int m = 0; m < 4; ++m) _Pragma("unroll") for (int k = 0; k < 2; ++k) dst[m][k] = *(const PG8_LAS bf16x8*)(lds + PG8_SA(b, h) + aoff + m * 2048 + k * 1024); } while (0)
#define PG8_LDB(dst, b, h) do { _Pragma("unroll") for (int n = 0; n < 2; ++n) _Pragma("unroll") for (int k = 0; k < 2; ++k) dst[n][k] = *(const PG8_LAS bf16x8*)(lds + PG8_SB(b, h) + boff + n * 2048 + k * 1024); } while (0)
#define PG8_MMA(ai, bj, At, Bt) do { __builtin_amdgcn_s_setprio(1); _Pragma("unroll") for (int m = 0; m < 4; ++m) _Pragma("unroll") for (int n = 0; n < 2; ++n) _Pragma("unroll") for (int k = 0; k < 2; ++k) \
        acc[ai][bj][m][n] = __builtin_amdgcn_mfma_f32_16x16x32_bf16(Bt[n][k], At[m][k], acc[ai][bj][m][n], 0, 0, 0); __builtin_amdgcn_s_setprio(0); } while (0)
#define PG8_WAIT_V(n) asm volatile("s_waitcnt vmcnt(" #n ")" ::: "memory")
#define PG8_WAIT_L(n) asm volatile("s_waitcnt lgkmcnt(" #n ")" ::: "memory")
#define PG8_BAR __builtin_amdgcn_s_barrier()
#define PG8_SCHED __builtin_amdgcn_sched_barrier(0)
    Unit cur, nxt; int ui = 0;
    if (!S.next(0, cur)) return;
    f32x4 acc[2][2][4][2];
#pragma unroll
    for (int a = 0; a < 2; ++a)
#pragma unroll
        for (int b = 0; b < 2; ++b)
#pragma unroll
            for (int m = 0; m < 4; ++m)
#pragma unroll
                for (int n = 0; n < 2; ++n) acc[a][b][m][n] = (f32x4){0.f, 0.f, 0.f, 0.f};
    bf16x8 At[4][2], B0[2][2], B1[2][2];
    const char* cA = (const char*)g.A + (size_t)cur.pm * tstep; const char* cB = (const char*)g.Bt + (size_t)cur.pn * tstep;
    S.a_ready(cur);
    if constexpr (SP2) {
        PG8_STAGE(PG8_SB(0, 0), cB, voffB); PG8_STAGE(PG8_SB(0, 1), cB + hstep, voffB); PG8_STAGE(PG8_SA(0, 0), cA, voffA); PG8_STAGE(PG8_SA(0, 1), cA + hstep, voffA);
        if (wr == 1) PG8_BAR;
        PG8_WAIT_V(2); PG8_BAR;
        PG8_STAGE(PG8_SB(1, 0), cB + kstep, voffB); PG8_STAGE(PG8_SA(1, 0), cA + kstep, voffA); PG8_STAGE(PG8_SB(1, 1), cB + hstep + kstep, voffB);
        PG8_WAIT_V(6); PG8_BAR;
    } else {
        PG8_STAGE(PG8_SB(0, 0), cB, voffB); PG8_STAGE(PG8_SA(0, 0), cA, voffA); PG8_STAGE(PG8_SB(0, 1), cB + hstep, voffB); PG8_STAGE(PG8_SA(0, 1), cA + hstep, voffA);
        if (wr == 1) PG8_BAR;
        PG8_WAIT_V(4); PG8_BAR;
        PG8_STAGE(PG8_SB(1, 0), cB + kstep, voffB); PG8_STAGE(PG8_SA(1, 0), cA + kstep, voffA); PG8_STAGE(PG8_SB(1, 1), cB + hstep + kstep, voffB);
        PG8_WAIT_V(6); PG8_BAR;
    }
    for (;;) {
        const bool has_next = S.next(ui + 1, nxt);
        const char* nA = has_next ? (const char*)g.A + (size_t)nxt.pm * tstep : cA; const char* nB = has_next ? (const char*)g.Bt + (size_t)nxt.pn * tstep : cB;
        for (int t = 0; t < nt; t += 2) {
            const bool last = (t == nt - 2);
            const char* a1 = cA + (size_t)(t + 1) * kstep;
            const char* a2 = last ? nA : cA + (size_t)(t + 2) * kstep; const char* b2 = last ? nB : cB + (size_t)(t + 2) * kstep;
            const char* a3 = a2 + kstep; const char* b3 = b2 + kstep;
            if (last && has_next) S.a_ready(nxt);
            if constexpr (SP2) {
            PG8_LDB(B0, 0, 0); PG8_LDB(B1, 0, 1); PG8_SCHED; PG8_LDA(At, 0, 0); PG8_STAGE(PG8_SA(1, 1), a1 + hstep, voffA);
            PG8_WAIT_V(8); PG8_WAIT_L(0); PG8_BAR; PG8_MMA(0, 0, At, B0); PG8_MMA(0, 1, At, B1); PG8_BAR; PG8_SCHED;
            PG8_LDA(At, 0, 1); PG8_STAGE(PG8_SB(0, 0), b2, voffB); PG8_STAGE(PG8_SB(0, 1), b2 + hstep, voffB); PG8_STAGE(PG8_SA(0, 0), a2, voffA);
            PG8_WAIT_V(8); PG8_WAIT_L(0); PG8_BAR; PG8_MMA(1, 0, At, B0); PG8_MMA(1, 1, At, B1); PG8_BAR; PG8_SCHED;
            PG8_LDB(B0, 1, 0); PG8_LDB(B1, 1, 1); PG8_SCHED; PG8_LDA(At, 1, 0); PG8_STAGE(PG8_SA(0, 1), a2 + hstep, voffA);
            PG8_WAIT_V(8); PG8_WAIT_L(0); PG8_BAR; PG8_MMA(0, 0, At, B0); PG8_MMA(0, 1, At, B1); PG8_BAR; PG8_SCHED;
            PG8_LDA(At, 1, 1); PG8_STAGE(PG8_SB(1, 0), b3, voffB); PG8_STAGE(PG8_SB(1, 1), b3 + hstep, voffB); PG8_STAGE(PG8_SA(1, 0), a3, voffA);
            PG8_WAIT_V(8); PG8_WAIT_L(0); PG8_BAR; PG8_MMA(1, 0, At, B0); PG8_MMA(1, 1, At, B1); PG8_BAR; PG8_SCHED;
            } else {
            PG8_LDB(B0, 0, 0); PG8_SCHED; PG8_LDA(At, 0, 0); PG8_STAGE(PG8_SA(1, 1), a1 + hstep, voffA);
            PG8_WAIT_L(8); PG8_BAR; PG8_WAIT_L(0); PG8_MMA(0, 0, At, B0); PG8_BAR; PG8_SCHED;
            PG8_LDB(B1, 0, 1); PG8_STAGE(PG8_SB(0, 0), b2, voffB);
            PG8_BAR; PG8_WAIT_L(0); PG8_MMA(0, 1, At, B1); PG8_BAR;
            PG8_LDA(At, 0, 1); PG8_STAGE(PG8_SA(0, 0), a2, voffA);
            PG8_BAR; PG8_WAIT_L(0); PG8_MMA(1, 0, At, B0); PG8_BAR; PG8_SCHED;
            PG8_STAGE(PG8_SB(0, 1), b2 + hstep, voffB);
            PG8_WAIT_V(6); PG8_BAR; PG8_MMA(1, 1, At, B1); PG8_BAR;
            PG8_LDB(B0, 1, 0); PG8_SCHED; PG8_LDA(At, 1, 0); PG8_STAGE(PG8_SA(0, 1), a2 + hstep, voffA);
            PG8_WAIT_L(8); PG8_BAR; PG8_WAIT_L(0); PG8_MMA(0, 0, At, B0); PG8_BAR; PG8_SCHED;
            PG8_LDB(B1, 1, 1); PG8_STAGE(PG8_SB(1, 0), b3, voffB);
            PG8_BAR; PG8_WAIT_L(0); PG8_MMA(0, 1, At, B1); PG8_BAR;
            PG8_LDA(At, 1, 1); PG8_STAGE(PG8_SA(1, 0), a3, voffA);
            PG8_BAR; PG8_WAIT_L(0); PG8_MMA(1, 0, At, B0); PG8_BAR; PG8_SCHED;
            PG8_STAGE(PG8_SB(1, 1), b3 + hstep, voffB);
            PG8_WAIT_V(6); PG8_BAR; PG8_MMA(1, 1, At, B1); PG8_BAR;
            }
        }
        if constexpr (ALIGN_EPI) { if (wr == 0) PG8_BAR; }
        if constexpr (!Epi::AFTER_DRAIN) { E(acc, cur, wr, wc, fr, fq); S.done(cur); }
        if (!has_next) break;
#pragma unroll
        for (int a = 0; a < 2; ++a)
#pragma unroll
            for (int b = 0; b < 2; ++b)
#pragma unroll
                for (int m = 0; m < 4; ++m)
#pragma unroll
                    for (int n = 0; n < 2; ++n) acc[a][b][m][n] = (f32x4){0.f, 0.f, 0.f, 0.f};
        cur = nxt; cA = nA; cB = nB; ++ui;
        if constexpr (ALIGN_EPI) { if (wr == 1) PG8_BAR; }
    }
    PG8_WAIT_V(0);
    if constexpr (!ALIGN_EPI) { if (wr == 0) PG8_BAR; }
    PG8_BAR;
    if constexpr (Epi::AFTER_DRAIN) { E.fused(acc, cur, wr, wc, fr, fq, lds, wid, lane); S.done(cur); }
#undef PG8_SA
#undef PG8_SB
#undef PG8_STAGE
#undef PG8_LDA
#undef PG8_LDB
#undef PG8_MMA
#undef PG8_WAIT_V
#undef PG8_WAIT_L
#undef PG8_BAR
#undef PG8_SCHED
}
}

#define LAS __attribute__((address_space(3)))
typedef unsigned short bf16;
typedef unsigned u32x4 __attribute__((ext_vector_type(4)));
typedef unsigned u32x2 __attribute__((ext_vector_type(2)));
typedef float f32x4 __attribute__((ext_vector_type(4)));
typedef float f32x16 __attribute__((ext_vector_type(16)));
typedef short bf16x8 __attribute__((ext_vector_type(8)));
using pg8::pk_bf16;
#define MFMA32(a, b, c) __builtin_amdgcn_mfma_f32_32x32x16_bf16((a), (b), (c), 0, 0, 0)

#ifndef PROBE_M1
#define PROBE_M1 1
#endif
#ifndef PROBE_SCAN
#define PROBE_SCAN 1
#endif
#ifndef PROBE_G1
#define PROBE_G1 1
#endif
#ifndef PROBE_G3
#define PROBE_G3 1
#endif
constexpr int MTOK = 65536, DM = 1024, NLAYER = 4, TSEQ = 8192, FF = 2816, NIN = 3840, NGU = 5632;
constexpr size_t MiB = (size_t)1 << 20;
constexpr size_t WS_CTL = 0, WS_W = 1 * MiB, LW = 27262976, LW_IN = 0, LW_OUT = 7864320, LW_GU = 9961472, LW_DN = 21495808;
constexpr size_t WS_XB = 105 * MiB, WS_SS = 233 * MiB, WS_BG = 234 * MiB, WS_PA = 236 * MiB, WS_MIX = 236 * MiB, WS_PZ = 428 * MiB, WS_PS = 492 * MiB, WS_INTER = 684 * MiB, WS_ACT = 236 * MiB, WS_SSP1 = 972 * MiB, WS_SSP2 = 976 * MiB, WS_END = 980 * MiB;
static_assert(WS_W + 4 * LW <= WS_XB, "weights fit");
constexpr int UNIT_BYTES = 73728;
constexpr int LDS_BYTES = 147456;
constexpr float QSCALE = 0.08838834764831845f;

__device__ __forceinline__ float bf2f(unsigned short v) { return __uint_as_float((unsigned)v << 16); }
__device__ __forceinline__ float bflo(unsigned w) { return __uint_as_float(w << 16); }
__device__ __forceinline__ float bfhi(unsigned w) { return __uint_as_float(w & 0xffff0000u); }
__device__ __forceinline__ unsigned short f2bf(float f) { return (unsigned short)(pk_bf16(f, 0.f) & 0xffffu); }
__device__ __forceinline__ float wave_sum(float v) {
#pragma unroll
    for (int o = 1; o < 64; o <<= 1) v += __shfl_xor(v, o);
    return v;
}
__device__ __forceinline__ float sum16(float v) { v += __shfl_xor(v, 1); v += __shfl_xor(v, 2); v += __shfl_xor(v, 4); v += __shfl_xor(v, 8); return v; }
__device__ __forceinline__ constexpr int crow(int reg, int h) { return (reg & 3) + 8 * (reg >> 2) + 4 * h; }
__device__ __forceinline__ bf16x8 pack_step(const f32x16& x, int s) {
    u32x4 p; p.x = pk_bf16(x[8 * s], x[8 * s + 1]); p.y = pk_bf16(x[8 * s + 2], x[8 * s + 3]); p.z = pk_bf16(x[8 * s + 4], x[8 * s + 5]); p.w = pk_bf16(x[8 * s + 6], x[8 * s + 7]);
    return __builtin_bit_cast(bf16x8, p);
}
#define LDS_WAIT() asm volatile("s_waitcnt lgkmcnt(0)" ::: "memory")
#define LDS_BAR() do { asm volatile("s_waitcnt lgkmcnt(0)" ::: "memory"); __builtin_amdgcn_s_barrier(); asm volatile("" ::: "memory"); } while (0)
__device__ __forceinline__ unsigned char* launder_p(unsigned char* p) { asm volatile("" : "+s"(p)); return p; }
__device__ __forceinline__ int launder_i(int i) { asm volatile("" : "+s"(i)); return i; }
#define INP(k) (a.in[launder_i(k)])
__device__ __forceinline__ int launder_v(int i) { asm volatile("" : "+v"(i)); return i; }
__device__ __forceinline__ int fresh_tid(int wave_s) { unsigned ones = ~0u; asm volatile("" : "+s"(ones)); return (wave_s << 6) | (int)__builtin_amdgcn_mbcnt_hi(ones, __builtin_amdgcn_mbcnt_lo(ones, 0u)); }

__device__ __forceinline__ void transpose_item(const float* W, int ldw, int sc, const float* gain, bf16* dst, int K, int k0, LAS float* scr, int lane) {
    float wv[32];
#pragma unroll
    for (int i = 0; i < 32; ++i) { const int kk = 2 * i + (lane >> 5); wv[i] = 0.f; if (sc >= 0) wv[i] = *(const __attribute__((address_space(1))) float*)(W + (size_t)(k0 + kk) * ldw + sc); }
#pragma unroll
    for (int i = 0; i < 32; ++i) { const int kk = 2 * i + (lane >> 5); float v = wv[i]; if (gain) v *= gain[k0 + kk]; scr[kk * 33 + (lane & 31)] = v; }
    LDS_WAIT(); asm volatile("" ::: "memory");
    const int c = lane & 7;
#pragma unroll
    for (int j = 0; j < 4; ++j) { const int n = (lane >> 3) + 8 * j; const LAS float* s = scr + (8 * c) * 33 + n;
        u32x4 o; o.x = pk_bf16(s[0 * 33], s[1 * 33]); o.y = pk_bf16(s[2 * 33], s[3 * 33]); o.z = pk_bf16(s[4 * 33], s[5 * 33]); o.w = pk_bf16(s[6 * 33], s[7 * 33]);
        *(u32x4*)(dst + (size_t)n * K + k0 + 8 * c) = o; }
    LDS_WAIT(); asm volatile("" ::: "memory");
}

struct Args { const float* in[15]; float* out; unsigned char* ws; };

__device__ __forceinline__ void p0_prologue(const Args& a, LAS unsigned char* lds, int G, int bx, int tid) {
    const int lane = tid & 63, wave = tid >> 6;
    LAS float* scr = (LAS float*)(lds + wave * 16384);
    const int gw = bx * 8 + wave, NGW = G * 8;
    constexpr int I_IN = 16 * 120, I_OUT = 16 * 32, I_GU = 16 * 176, I_DN = 44 * 32, LI = I_IN + I_OUT + I_GU + I_DN;
    unsigned char* wsw = launder_p(a.ws) + WS_W;
    for (int it = gw; it < NLAYER * LI; it += NGW) {
        const int l = it / LI; int r = it % LI; const int cl = lane & 31;
        unsigned char* wl = wsw + (size_t)l * LW;
        if (r < I_IN) { const int kb = r / 120, nb = r % 120, n = nb * 32 + cl;
            const int sc = n < 2048 ? n : (n < 3584 ? n + 8 : (n < 3592 ? n - 3584 + 2048 : -1));
            transpose_item(a.in[2] + (size_t)l * 1024 * 3592, 3592, sc, a.in[1] + l * 1024, (bf16*)(wl + LW_IN) + (size_t)nb * 32 * 1024, 1024, kb * 64, scr, lane); continue; }
        r -= I_IN;
        if (r < I_OUT) { const int kb = r / 32, nb = r % 32;
            transpose_item(a.in[9] + (size_t)l * 1024 * 1024, 1024, nb * 32 + cl, nullptr, (bf16*)(wl + LW_OUT) + (size_t)nb * 32 * 1024, 1024, kb * 64, scr, lane); continue; }
        r -= I_OUT;
        if (r < I_GU) { const int kb = r / 176, nb = r % 176, R0 = nb * 32, pn = R0 >> 8, rr = R0 & 255, bj = rr >> 7, j0 = rr & 127;
            const float* Wsrc = (bj ? a.in[12] : a.in[11]) + (size_t)l * 1024 * 2816;
            transpose_item(Wsrc, 2816, 128 * pn + j0 + cl, a.in[10] + l * 1024, (bf16*)(wl + LW_GU) + (size_t)R0 * 1024, 1024, kb * 64, scr, lane); continue; }
        r -= I_GU;
        { const int kb = r / 32, nb = r % 32;
            transpose_item(a.in[13] + (size_t)l * 2816 * 1024, 1024, nb * 32 + cl, nullptr, (bf16*)(wl + LW_DN) + (size_t)nb * 32 * 2816, 2816, kb * 64, scr, lane); }
    }
    const float* x = a.in[0]; bf16* XB = (bf16*)(a.ws + WS_XB); float* SS1 = (float*)(a.ws + WS_SSP1);
    for (int m = gw; m < MTOK; m += NGW) {
        const f32x4* xr = (const f32x4*)(x + (size_t)m * DM) + lane; f32x4 v[4]; float s = 0.f;
#pragma unroll
        for (int j = 0; j < 4; ++j) { v[j] = xr[64 * j]; s += (v[j].x * v[j].x + v[j].y * v[j].y) + (v[j].z * v[j].z + v[j].w * v[j].w); }
        s = wave_sum(s); if (lane < 16) SS1[(size_t)m * 16 + lane] = lane == 0 ? s : 0.f;
        u32x2* o8 = (u32x2*)(XB + (size_t)m * DM) + lane;
#pragma unroll
        for (int j = 0; j < 4; ++j) { u32x2 o; o.x = pk_bf16(v[j].x, v[j].y); o.y = pk_bf16(v[j].z, v[j].w); o8[64 * j] = o; }
    }
}

constexpr int M1_RAW = 0, M1_AMAT = 0, M1_QKM = 17408, M1_WS = 26624, M1_QS = 51712, M1_KS = 69120, M1_VS = 86528, M1_GC = 103936, M1_BETA = 104192, M1_EG = 104448, M1_BEG = 104704, M1_CW = 106496  , ROWB = 272;

typedef float f32x2v __attribute__((ext_vector_type(2)));
template <int C> struct SolveRows {
    static __device__ __forceinline__ void run(f32x2v (&X2)[32], f32x4 (&cur)[16], LAS unsigned char* lds, const LAS unsigned short* src, const LAS float* fac) {
        f32x4 nxt[16];
#pragma unroll
        for (int q = 0; q < 16; ++q) if (C + 1 < 64 && 4 * q < C + 1) nxt[q] = *(const LAS f32x4*)(lds + M1_AMAT + ((C + 1) * 68 + 4 * q) * 4);
        const float rhs = bf2f(src[C * 136]) * fac[C];
        f32x2v acc0 = {0.f, 0.f}, acc1 = {0.f, 0.f}, acc2 = {0.f, 0.f}, acc3 = {0.f, 0.f};
#pragma unroll
        for (int q = 0; q < 16; ++q) if (4 * q < C) { const f32x4 av = cur[q];
            if (q & 1) { acc2 -= (f32x2v){av.x, av.y} * X2[2 * q]; if (4 * q + 2 < C) acc3 -= (f32x2v){av.z, av.w} * X2[2 * q + 1]; }
            else { acc0 -= (f32x2v){av.x, av.y} * X2[2 * q]; if (4 * q + 2 < C) acc1 -= (f32x2v){av.z, av.w} * X2[2 * q + 1]; } }
        acc0 += acc1; acc2 += acc3; acc0 += acc2;
        float xc = rhs + (acc0.x + acc0.y);
        asm volatile("" : "+v"(xc) :: "memory");
        X2[C >> 1][C & 1] = xc;
#pragma unroll
        for (int q = 0; q < 16; ++q) if (C + 1 < 64 && 4 * q < C + 1) cur[q] = nxt[q];
        if constexpr (C + 1 < 64) SolveRows<C + 1>::run(X2, cur, lds, src, fac);
    }
};

__device__ __forceinline__ void m1_unit(LAS unsigned char* lds, int unit, const bf16* PA, const float* BG, const float* convw, unsigned char* inter, float* glast, int tid_in) {
    int tid = tid_in; asm volatile("" : "+v"(tid));
    const int b = unit >> 9, n = (unit >> 2) & 127, h = unit & 3;
    const int lane = tid & 63, wave = __builtin_amdgcn_readfirstlane(tid >> 6);
    const size_t row0 = (size_t)b * TSEQ + n * 64;
    LAS float* GC = (LAS float*)(lds + M1_GC); LAS float* BETA = (LAS float*)(lds + M1_BETA); LAS float* EG = (LAS float*)(lds + M1_EG); LAS float* BEG = (LAS float*)(lds + M1_BEG);
    unsigned char* ub = inter + (size_t)unit * UNIT_BYTES;
    float bt = 0.f, gv = 0.f;
    if (wave == 0) { bt = BG[(row0 + lane) * 8 + h]; gv = BG[(row0 + lane) * 8 + 4 + h]; }
    {
        u32x4 rv[7];
#pragma unroll
        for (int it = 0; it < 7; ++it) {
            const int idx = tid + 512 * it, row = idx / 48, rem = idx % 48, seg = rem >> 4, part = rem & 15, t = n * 64 - 3 + row;
            rv[it] = (u32x4){0u, 0u, 0u, 0u};
            if (idx < 67 * 48 && t >= 0) rv[it] = *(const __attribute__((address_space(1))) u32x4*)(PA + ((size_t)b * TSEQ + t) * 1536 + seg * 512 + h * 128 + part * 8);
        }
#pragma unroll
        for (int it = 0; it < 7; ++it) {
            const int idx = tid + 512 * it, row = idx / 48, rem = idx % 48, seg = rem >> 4, part = rem & 15;
            if (idx < 67 * 48) *(LAS u32x4*)(lds + M1_RAW + row * 768 + seg * 256 + part * 16) = rv[it];
        }
    }
    if (wave == 0) {
#pragma unroll
        for (int off = 1; off < 64; off <<= 1) { const int srcl = lane >= off ? lane - off : lane; const float t = __int_as_float(__builtin_amdgcn_ds_bpermute(srcl << 2, __float_as_int(gv))); if (lane >= off) gv += t; }
        const float eg = __expf(gv);
        GC[lane] = gv; BETA[lane] = bt; EG[lane] = eg; BEG[lane] = bt * eg;
    }
    LDS_BAR();
    {
        const int j = tid & 15, cb = tid >> 4;
#pragma unroll 1
        for (int s = 0; s < 3; ++s) {
            float cw[4][8];
#pragma unroll
            for (int tap = 0; tap < 4; ++tap) { const LAS float* wp = (const LAS float*)(lds + M1_CW) + (h * 4 + tap) * 384 + s * 128 + 8 * j; const f32x4 w0 = *(const LAS f32x4*)wp, w1 = *(const LAS f32x4*)(wp + 4);
                cw[tap][0] = w0.x; cw[tap][1] = w0.y; cw[tap][2] = w0.z; cw[tap][3] = w0.w; cw[tap][4] = w1.x; cw[tap][5] = w1.y; cw[tap][6] = w1.z; cw[tap][7] = w1.w; }
            const int dstoff = s == 0 ? M1_QS : (s == 1 ? M1_KS : M1_VS);
#pragma unroll
            for (int pass = 0; pass < 2; ++pass) {
                const int c = cb + 32 * pass; float y[8];
#pragma unroll
                for (int e = 0; e < 8; ++e) y[e] = 0.f;
#pragma unroll
                for (int tap = 0; tap < 4; ++tap) { const u32x4 xv = *(const LAS u32x4*)(lds + M1_RAW + (c + tap) * 768 + s * 256 + j * 16);
                    y[0] += cw[tap][0] * bflo(xv.x); y[1] += cw[tap][1] * bfhi(xv.x); y[2] += cw[tap][2] * bflo(xv.y); y[3] += cw[tap][3] * bfhi(xv.y);
                    y[4] += cw[tap][4] * bflo(xv.z); y[5] += cw[tap][5] * bfhi(xv.z); y[6] += cw[tap][6] * bflo(xv.w); y[7] += cw[tap][7] * bfhi(xv.w); }
                float ssq = 0.f;
#pragma unroll
                for (int e = 0; e < 8; ++e) { y[e] = y[e] * __builtin_amdgcn_rcpf(1.0f + __expf(-y[e])); ssq += y[e] * y[e]; }
                ssq = sum16(ssq);
                const float rn = (s < 2) ? rsqrtf(ssq + 1e-6f) : 1.0f;
                u32x4 o; o.x = pk_bf16(y[0] * rn, y[1] * rn); o.y = pk_bf16(y[2] * rn, y[3] * rn); o.z = pk_bf16(y[4] * rn, y[5] * rn); o.w = pk_bf16(y[6] * rn, y[7] * rn);
                *(LAS u32x4*)(lds + dstoff + c * ROWB + j * 16) = o;
            }
        }
    }
    LDS_BAR();
    {
        const int r = lane & 31, hh = lane >> 5, w4 = wave & 3, ti = w4 >> 1, tj = w4 & 1; const bool isqk = wave >= 4, upper = (ti == 0 && tj == 1);
        if (isqk || !upper) {
            f32x16 x;
#pragma unroll
            for (int i = 0; i < 16; ++i) x[i] = 0.f;
            if (!upper) {
                const LAS unsigned char* Ab = lds + (isqk ? M1_QS : M1_KS) + (32 * ti + r) * ROWB + hh * 16;
                const LAS unsigned char* Bb = lds + M1_KS + (32 * tj + r) * ROWB + hh * 16;
#pragma unroll
                for (int s = 0; s < 8; ++s) { const bf16x8 av = *(const LAS bf16x8*)(Ab + s * 32), bv = *(const LAS bf16x8*)(Bb + s * 32); x = MFMA32(av, bv, x); }
            }
            const int m = 32 * tj + r; const float gm = GC[m];
            float gcv[16], btv[16];
#pragma unroll
            for (int i = 0; i < 16; ++i) { const int c = 32 * ti + crow(i, hh); gcv[i] = GC[c]; btv[i] = BETA[c]; }
#pragma unroll
            for (int i = 0; i < 16; ++i) { const int c = 32 * ti + crow(i, hh); const float dec = __expf(gcv[i] - gm);
                if (!isqk) { const float val = (m < c) ? btv[i] * x[i] * dec : 0.f; *(LAS float*)(lds + M1_AMAT + (c * 68 + m) * 4) = val; }
                else { const float val = (m <= c) ? x[i] * QSCALE * dec : 0.f; *(LAS unsigned short*)(lds + M1_QKM + (c * 72 + m) * 2) = f2bf(val); } }
        }
    }
    LDS_BAR();
    asm volatile("" : "+v"(tid));
    f32x2v X2[32];
#pragma unroll
    for (int k = 0; k < 32; ++k) X2[k] = (f32x2v){0.f, 0.f};
#define X(i) (X2[(i) >> 1][(i) & 1])
    if (tid < 256) {
        unsigned srcoff = (tid < 128 ? M1_VS : M1_KS) + (tid & 127) * 2, facoff = tid < 128 ? M1_BETA : M1_BEG;
        asm volatile("" : "+v"(srcoff), "+v"(facoff));
        const LAS unsigned short* src = (const LAS unsigned short*)(lds + srcoff);
        const LAS float* fac = (const LAS float*)(lds + facoff);
        f32x4 cur[16];
        SolveRows<0>::run(X2, cur, lds, src, fac);
    } else {
        const int t2 = tid - 256; const float glc = GC[63];
#pragma unroll
        for (int it = 0; it < 4; ++it) {
            const int idx = t2 + 256 * it, frag = idx >> 6, l2 = idx & 63, tt = frag >> 2, ks = frag & 3, nn = l2 & 15, qq = l2 >> 4, c = 16 * tt + nn, dk0 = 32 * ks + 4 * qq;
            const u32x2 p0 = *(const LAS u32x2*)(lds + M1_QS + c * ROWB + dk0 * 2), p1 = *(const LAS u32x2*)(lds + M1_QS + c * ROWB + (dk0 + 16) * 2);
            const float f = QSCALE * EG[c];
            u32x4 o; o.x = pk_bf16(bflo(p0.x) * f, bfhi(p0.x) * f); o.y = pk_bf16(bflo(p0.y) * f, bfhi(p0.y) * f); o.z = pk_bf16(bflo(p1.x) * f, bfhi(p1.x) * f); o.w = pk_bf16(bflo(p1.y) * f, bfhi(p1.y) * f);
            *(u32x4*)(ub + 16384 + idx * 16) = o;
        }
#pragma unroll
        for (int it = 0; it < 4; ++it) {
            const int idx = t2 + 256 * it, frag = idx >> 6, l2 = idx & 63, t8 = frag >> 1, ks = frag & 1, nn = l2 & 15, qq = l2 >> 4, dk = 16 * t8 + nn;
            float v[8];
#pragma unroll
            for (int e = 0; e < 8; ++e) { const int tok = 32 * ks + 16 * (e >> 2) + 4 * qq + (e & 3); v[e] = bf2f(*(const LAS unsigned short*)(lds + M1_KS + tok * ROWB + dk * 2)) * __expf(glc - GC[tok]); }
            u32x4 o; o.x = pk_bf16(v[0], v[1]); o.y = pk_bf16(v[2], v[3]); o.z = pk_bf16(v[4], v[5]); o.w = pk_bf16(v[6], v[7]);
            *(u32x4*)(ub + 32768 + idx * 16) = o;
        }
#pragma unroll
        for (int it = 0; it < 2; ++it) {
            const int idx = t2 + 256 * it, frag = idx >> 6, l2 = idx & 63, tt = frag >> 1, ks = frag & 1, nn = l2 & 15, qq = l2 >> 4, c = 16 * tt + nn, m0 = 32 * ks + 4 * qq;
            const u32x2 p0 = *(const LAS u32x2*)(lds + M1_QKM + (c * 72 + m0) * 2), p1 = *(const LAS u32x2*)(lds + M1_QKM + (c * 72 + m0 + 16) * 2);
            u32x4 o; o.x = p0.x; o.y = p0.y; o.z = p1.x; o.w = p1.y;
            *(u32x4*)(ub + 49152 + idx * 16) = o;
        }
    }
    LDS_BAR();
    asm volatile("" : "+v"(tid));
    if (tid < 128) {
        const int sl = tid >> 4, nn = tid & 15; unsigned char* ubU = ub + 57344 + sl * 2048;
#pragma unroll
        for (int qq = 0; qq < 4; ++qq) {
            u32x4 o0, o1;
            o0.x = pk_bf16(X(4 * qq), X(4 * qq + 1)); o0.y = pk_bf16(X(4 * qq + 2), X(4 * qq + 3)); o0.z = pk_bf16(X(16 + 4 * qq), X(16 + 4 * qq + 1)); o0.w = pk_bf16(X(16 + 4 * qq + 2), X(16 + 4 * qq + 3));
            o1.x = pk_bf16(X(32 + 4 * qq), X(32 + 4 * qq + 1)); o1.y = pk_bf16(X(32 + 4 * qq + 2), X(32 + 4 * qq + 3)); o1.z = pk_bf16(X(48 + 4 * qq), X(48 + 4 * qq + 1)); o1.w = pk_bf16(X(48 + 4 * qq + 2), X(48 + 4 * qq + 3));
            u32x4* dst = (u32x4*)(ubU + (qq * 16 + nn) * 32); dst[0] = o0; dst[1] = o1;
        }
    } else if (tid < 256) {
        const int d = tid - 128;
#pragma unroll
        for (int c = 0; c < 64; ++c) *(LAS unsigned short*)(lds + M1_WS + c * ROWB + d * 2) = f2bf(X(c));
    } else if (tid == 256) glast[unit] = __expf(GC[63]);
    LDS_BAR();
    asm volatile("" : "+v"(tid));
#pragma unroll
    for (int it = 0; it < 2; ++it) {
        const int idx = tid + 512 * it, frag = idx >> 6, l2 = idx & 63, tt = frag >> 2, ks = frag & 3, nn = l2 & 15, qq = l2 >> 4, c = 16 * tt + nn, dk0 = 32 * ks + 4 * qq;
        const u32x2 p0 = *(const LAS u32x2*)(lds + M1_WS + c * ROWB + dk0 * 2), p1 = *(const LAS u32x2*)(lds + M1_WS + c * ROWB + (dk0 + 16) * 2);
        u32x4 o; o.x = p0.x; o.y = p0.y; o.z = p1.x; o.w = p1.y;
        *(u32x4*)(ub + idx * 16) = o;
    }
    LDS_BAR();
#undef X
}

constexpr int SC_BUF = 61440, SC_CTL = 131072;
#define MFMA16(a, b, c) __builtin_amdgcn_mfma_f32_16x16x32_bf16((a), (b), (c), 0, 0, 0)
__device__ __forceinline__ bf16x8 pack4(const f32x4& a, const f32x4& b) { u32x4 p; p.x = pk_bf16(a[0], a[1]); p.y = pk_bf16(a[2], a[3]); p.z = pk_bf16(b[0], b[1]); p.w = pk_bf16(b[2], b[3]); return __builtin_bit_cast(bf16x8, p); }
__device__ __forceinline__ const unsigned char* scan_piece(const unsigned char* ub, int half, int p) { return ub + (p < 56 ? p * 1024 : 57344 + half * 4096 + (p - 56) * 1024); }
__device__ __forceinline__ void scan_issue(LAS unsigned char* lds, const unsigned char* ub, int half, int buf, int wave, int lane) {
#pragma unroll
    for (int k = 0; k < 8; ++k) { const int p = wave + 8 * k;
        if (p < 60) __builtin_amdgcn_global_load_lds((const unsigned*)(scan_piece(ub, half, p) + lane * 16), (LAS unsigned*)(lds + buf * SC_BUF + p * 1024), 16, 0, 0); }
}
__device__ __forceinline__ void scan_prefetch(LAS unsigned char* lds, const unsigned char* ub, int half, int wave, int lane) {
#pragma unroll
    for (int k = 0; k < 2; ++k) { const int g8 = (wave - 4) * 2 + k;
        const unsigned char* src = ub + (g8 < 7 ? g8 * 8192 : 57344 + half * 4096) + lane * 128;
        __builtin_amdgcn_global_load_lds((const unsigned*)src, (LAS unsigned*)(lds + SC_CTL + 2048 + wave * 1024), 4, 0, 0); }
}
#define FRAG(off) (*(const LAS bf16x8*)(L + (off) + lane * 16))
__device__ __forceinline__ void scan_unit(LAS unsigned char* lds, int bh, int half, const unsigned char* inter, const float* glast, bf16* MIX, int tid) {
    const int wave = __builtin_amdgcn_readfirstlane(tid >> 6), lane = tid & 63, b = bh >> 2, h = bh & 3, nn = lane & 15, qq = lane >> 4;
    f32x4 S[8];
#pragma unroll
    for (int d = 0; d < 8; ++d) S[d] = (f32x4){0.f, 0.f, 0.f, 0.f};
    const int unit0 = (b * 128) * 4 + h;
    LAS float* GLS = (LAS float*)(lds + SC_CTL + 256);
    if (tid < 128) GLS[tid] = glast[unit0 + 4 * tid];
    scan_issue(lds, inter + (size_t)unit0 * UNIT_BYTES, half, 0, wave, lane);
    if (false) { scan_prefetch(lds, inter + (size_t)(unit0 + 4) * UNIT_BYTES, half, wave, lane); scan_prefetch(lds, inter + (size_t)(unit0 + 8) * UNIT_BYTES, half, wave, lane); scan_prefetch(lds, inter + (size_t)(unit0 + 12) * UNIT_BYTES, half, wave, lane); }
    asm volatile("s_waitcnt vmcnt(0)" ::: "memory"); __syncthreads();
#pragma unroll 1
    for (int n = 0; n < 128; ++n) {
        const int buf = n & 1, unit = unit0 + n * 4;
        if (n + 1 < 128) scan_issue(lds, inter + (size_t)(unit + 4) * UNIT_BYTES, half, buf ^ 1, wave, lane);
        const bool pf = false;
        if (pf) scan_prefetch(lds, inter + (size_t)(unit + 16) * UNIT_BYTES, half, wave, lane);
        if (wave < 2) {
            const LAS unsigned char* L = lds + buf * SC_BUF;
            const float gl = GLS[n];
#define SB() __builtin_amdgcn_sched_barrier(0)
            bf16x8 R1[16], R2[16];
#pragma unroll
            for (int t = 0; t < 4; ++t) { R1[2 * t] = FRAG((4 * t) * 1024); R1[2 * t + 1] = FRAG((4 * t + 1) * 1024); R1[8 + 2 * t] = FRAG(16384 + (4 * t) * 1024); R1[8 + 2 * t + 1] = FRAG(16384 + (4 * t + 1) * 1024); }
#pragma unroll
            for (int t = 0; t < 4; ++t) { R2[2 * t] = FRAG((4 * t + 2) * 1024); R2[2 * t + 1] = FRAG((4 * t + 3) * 1024); R2[8 + 2 * t] = FRAG(16384 + (4 * t + 2) * 1024); R2[8 + 2 * t + 1] = FRAG(16384 + (4 * t + 3) * 1024); }
            SB();
            bf16x8 Sb[4];
#pragma unroll
            for (int s = 0; s < 4; ++s) Sb[s] = pack4(S[2 * s], S[2 * s + 1]);
            f32x4 P[4], O[4];
#pragma unroll
            for (int t = 0; t < 4; ++t) { P[t] = (f32x4){0.f, 0.f, 0.f, 0.f}; O[t] = (f32x4){0.f, 0.f, 0.f, 0.f}; }
            SB();
#pragma unroll
            for (int s = 0; s < 2; ++s) {
#pragma unroll
                for (int t = 0; t < 4; ++t) P[t] = MFMA16(R1[2 * t + s], Sb[s], P[t]);
#pragma unroll
                for (int t = 0; t < 4; ++t) O[t] = MFMA16(Sb[s], R1[8 + 2 * t + s], O[t]);
                SB();
            }
#pragma unroll
            for (int d = 0; d < 8; ++d) R1[d] = FRAG(32768 + (2 * d) * 1024);
#pragma unroll
            for (int t = 0; t < 4; ++t) R1[8 + t] = FRAG(49152 + (t * 2) * 1024);
            R1[12] = FRAG(49152 + 5 * 1024); R1[13] = FRAG(49152 + 7 * 1024);
            const LAS u32x4* up = (const LAS u32x4*)(L + 57344 + wave * 2048 + lane * 32);
            const u32x4 u0 = up[0], u1 = up[1];
            SB();
#pragma unroll
            for (int s = 0; s < 2; ++s) {
#pragma unroll
                for (int t = 0; t < 4; ++t) P[t] = MFMA16(R2[2 * t + s], Sb[2 + s], P[t]);
#pragma unroll
                for (int t = 0; t < 4; ++t) O[t] = MFMA16(Sb[2 + s], R2[8 + 2 * t + s], O[t]);
                SB();
            }
#pragma unroll
            for (int d = 0; d < 8; ++d) R2[d] = FRAG(32768 + (2 * d + 1) * 1024);
            SB();
            P[0] = (f32x4){bflo(u0.x), bfhi(u0.x), bflo(u0.y), bfhi(u0.y)} - P[0]; P[1] = (f32x4){bflo(u0.z), bfhi(u0.z), bflo(u0.w), bfhi(u0.w)} - P[1];
            P[2] = (f32x4){bflo(u1.x), bfhi(u1.x), bflo(u1.y), bfhi(u1.y)} - P[2]; P[3] = (f32x4){bflo(u1.z), bfhi(u1.z), bflo(u1.w), bfhi(u1.w)} - P[3];
            bf16x8 Vb[2]; Vb[0] = pack4(P[0], P[1]); Vb[1] = pack4(P[2], P[3]);
#pragma unroll
            for (int d = 0; d < 8; ++d) S[d] = S[d] * gl;
            SB();
#pragma unroll
            for (int d = 0; d < 8; ++d) S[d] = MFMA16(R1[d], Vb[0], S[d]);
#pragma unroll
            for (int t = 0; t < 4; ++t) O[t] = MFMA16(Vb[0], R1[8 + t], O[t]);
            SB();
#pragma unroll
            for (int d = 0; d < 8; ++d) S[d] = MFMA16(R2[d], Vb[1], S[d]);
            O[2] = MFMA16(Vb[1], R1[12], O[2]); O[3] = MFMA16(Vb[1], R1[13], O[3]);
            SB();
            bf16* orow = MIX + ((size_t)b * TSEQ + n * 64 + nn) * 1024 + h * 128 + (half * 2 + wave) * 16 + 4 * qq;
#pragma unroll
            for (int t = 0; t < 4; ++t) { u32x2 o; o.x = pk_bf16(O[t][0], O[t][1]); o.y = pk_bf16(O[t][2], O[t][3]); *(__attribute__((address_space(1))) u32x2*)(orow + (size_t)t * 16 * 1024) = o; }
#undef SB
        }
        if (wave < 2) asm volatile("s_waitcnt vmcnt(4) lgkmcnt(0)" ::: "memory");
        else if (pf) asm volatile("s_waitcnt vmcnt(2) lgkmcnt(0)" ::: "memory");
        else asm volatile("s_waitcnt vmcnt(0) lgkmcnt(0)" ::: "memory");
        __builtin_amdgcn_s_barrier(); asm volatile("" ::: "memory");
    }
    asm volatile("s_waitcnt vmcnt(0) lgkmcnt(0)" ::: "memory"); __syncthreads();
}
#undef FRAG

__device__ __forceinline__ void sc_chunk(int chunk, const bf16* PS, const float* scw, const float* scg, bf16* MIX, int tid) {
    const int wave = tid >> 6, lane = tid & 63, tq = lane >> 4, jj = lane & 15;
#pragma unroll 1
    for (int it = 0; it < 8; ++it) {
        const int wi = wave * 8 + it, quad = wi >> 2, grp = wi & 3;
        const int token = chunk * 64 + quad * 4 + tq, tin = token & (TSEQ - 1), ch = grp * 128 + 8 * jj;
        const bf16* base = PS + (size_t)token * 1536 + ch;
        const u32x4 Bv = *(const u32x4*)base;
        float cv[8];
#pragma unroll
        for (int e = 0; e < 8; ++e) cv[e] = 0.f;
#pragma unroll
        for (int d = 0; d < 3; ++d) {
            if (tin - d >= 0) {
                const u32x4 Cv = *(const u32x4*)(base - (size_t)d * 1536 + 512), Hv = *(const u32x4*)(base - (size_t)d * 1536 + 1024);
                const float* wp = scw + (2 - d) * 512 + ch; const f32x4 w0 = *(const f32x4*)wp, w1 = *(const f32x4*)(wp + 4);
                cv[0] += w0.x * (bflo(Cv.x) * bflo(Hv.x)); cv[1] += w0.y * (bfhi(Cv.x) * bfhi(Hv.x)); cv[2] += w0.z * (bflo(Cv.y) * bflo(Hv.y)); cv[3] += w0.w * (bfhi(Cv.y) * bfhi(Hv.y));
                cv[4] += w1.x * (bflo(Cv.z) * bflo(Hv.z)); cv[5] += w1.y * (bfhi(Cv.z) * bfhi(Hv.z)); cv[6] += w1.z * (bflo(Cv.w) * bflo(Hv.w)); cv[7] += w1.w * (bfhi(Cv.w) * bfhi(Hv.w));
            }
        }
        float y[8] = {bflo(Bv.x) * cv[0], bfhi(Bv.x) * cv[1], bflo(Bv.y) * cv[2], bfhi(Bv.y) * cv[3], bflo(Bv.z) * cv[4], bfhi(Bv.z) * cv[5], bflo(Bv.w) * cv[6], bfhi(Bv.w) * cv[7]};
        float ssq = 0.f;
#pragma unroll
        for (int e = 0; e < 8; ++e) ssq += y[e] * y[e];
        ssq = sum16(ssq);
        const float rn = rsqrtf(ssq * (1.0f / 128.0f) + 1e-6f);
        const f32x4 g0 = *(const f32x4*)(scg + ch), g1 = *(const f32x4*)(scg + ch + 4);
        u32x4 o; o.x = pk_bf16(y[0] * rn * g0.x, y[1] * rn * g0.y); o.y = pk_bf16(y[2] * rn * g0.z, y[3] * rn * g0.w); o.z = pk_bf16(y[4] * rn * g1.x, y[5] * rn * g1.y); o.w = pk_bf16(y[6] * rn * g1.z, y[7] * rn * g1.w);
        *(u32x4*)(MIX + (size_t)token * 1024 + 512 + ch) = o;
    }
}

#define XB_TMO      128
#define XB_XCNT(j)  (256  + 64 * (j))
#define XB_XSUB(j)  (1280 + 64 * (j))
#define XB_XGEN(j)  (2304 + 64 * (j))
#define XB_TOP      3328
#define XB_TOPGEN   3392
#define XCD_BAR_WORDS 3456
#define XB_SPIN_CAP (1u << 18)

__device__ __forceinline__ unsigned xb_ld(unsigned* p)              { return __hip_atomic_load(p, __ATOMIC_RELAXED, __HIP_MEMORY_SCOPE_AGENT); }
__device__ __forceinline__ unsigned xb_add(unsigned* p, unsigned v) { return __hip_atomic_fetch_add(p, v, __ATOMIC_RELAXED, __HIP_MEMORY_SCOPE_AGENT); }
__device__ __forceinline__ unsigned xb_xcc_id() { return (unsigned)__builtin_amdgcn_s_getreg((3 << 11) | 20) & 0xFu; }
#define XB_SPIN(cond, bar) do { unsigned _sp = 0; while (cond) { __builtin_amdgcn_s_sleep(1); \
    if ((++_sp & 255u) == 0u) { if (xb_ld(&(bar)[XB_TMO])) break; if (_sp > XB_SPIN_CAP) { atomicAdd(&(bar)[XB_TMO], 1u); break; } } } } while (0)

struct XcdBarrier {
    unsigned* bar; unsigned x;
    volatile LAS unsigned* st;
};

__device__ __forceinline__ XcdBarrier xcd_barrier_post(unsigned* bar, volatile LAS unsigned* st) {
    XcdBarrier b; b.bar = bar; b.x = xb_xcc_id(); b.st = st;
    if (threadIdx.x == 0) (void)xb_add(&bar[XB_XCNT(b.x)], 1u);
    return b;
}
__device__ __forceinline__ void xcd_barrier_complete(unsigned* bar, unsigned x, unsigned& nloc, unsigned& nx) {
    const unsigned G = gridDim.x * gridDim.y * gridDim.z;
    unsigned sum, cnt, mine, sp = 0u;
    for (;;) {
        sum = 0u; cnt = 0u; mine = 0u;
#pragma unroll
        for (unsigned j = 0; j < 16; ++j) { const unsigned c = xb_ld(&bar[XB_XCNT(j)]); sum += c; cnt += (c > 0u) ? 1u : 0u; mine = (j == x) ? c : mine; }
        if (sum == G) break;
        __builtin_amdgcn_s_sleep(1);
        if ((++sp & 255u) == 0u) { if (xb_ld(&bar[XB_TMO])) break; if (sp > XB_SPIN_CAP) { atomicAdd(&bar[XB_TMO], 1u); break; } }
    }
    nloc = mine > 0u ? mine : 1u; nx = cnt > 0u ? cnt : 1u;
}

__device__ __forceinline__ void xcd_barrier(const XcdBarrier& b) {
    asm volatile("s_waitcnt vmcnt(0)" ::: "memory");
    __syncthreads();
    if (threadIdx.x == 0) {
        unsigned* bar = b.bar;
        __builtin_amdgcn_s_waitcnt(0);
        unsigned nloc = b.st[0], nx = b.st[1];
        if (nloc == 0u) { xcd_barrier_complete(bar, b.x, nloc, nx); b.st[0] = nloc; b.st[1] = nx; }
        const unsigned old = xb_add(&bar[XB_XSUB(b.x)], 1u);
        const unsigned gen = old / nloc;
        if (old + 1u == (gen + 1u) * nloc) {
            __builtin_amdgcn_fence(__ATOMIC_RELEASE, "agent");
            asm volatile("s_waitcnt vmcnt(0)" ::: "memory");
            const unsigned og = xb_add(&bar[XB_TOP], 1u);
            const unsigned tg = og / nx;
            if (og + 1u == (tg + 1u) * nx) xb_add(&bar[XB_TOPGEN], 1u);
            else XB_SPIN(xb_ld(&bar[XB_TOPGEN]) == tg, bar);
            __builtin_amdgcn_fence(__ATOMIC_ACQUIRE, "agent");
            xb_add(&bar[XB_XGEN(b.x)], 1u);
            asm volatile("s_waitcnt vmcnt(0)" ::: "memory");
        } else {
            XB_SPIN(xb_ld(&bar[XB_XGEN(b.x)]) == gen, bar);
            __builtin_amdgcn_fence(__ATOMIC_ACQUIRE, "agent");
            asm volatile("s_waitcnt vmcnt(0)" ::: "memory");
        }
    }
    __syncthreads();
}

#define GRID_BAR() do { XcdBarrier _b; _b.bar = (unsigned*)(launder_p(a.ws) + WS_CTL + 4096); _b.x = xb_xcc_id(); _b.st = (volatile LAS unsigned*)(lds + 131072 + 1024); xcd_barrier(_b); } while (0)
__global__ void __launch_bounds__(512, 2) hybrid_fwd(Args a) {
    extern __shared__ __attribute__((aligned(16))) unsigned char lds_raw[];
    LAS unsigned char* lds = (LAS unsigned char*)lds_raw;
    cg::grid_group grid = cg::this_grid();
    const int tid0 = threadIdx.x;
    if (tid0 < 8) ((LAS unsigned*)(lds + 131072 + 1024))[tid0] = 0u;
    __syncthreads();
    grid.sync();
    (void)xcd_barrier_post((unsigned*)(launder_p(a.ws) + WS_CTL + 4096), (volatile LAS unsigned*)(lds + 131072 + 1024));
    const int wave_s = __builtin_amdgcn_readfirstlane(threadIdx.x >> 6), bx = blockIdx.x, G = gridDim.x;
#define tid fresh_tid(wave_s)
    p0_prologue(a, lds, G, bx, tid);
    GRID_BAR();

#pragma unroll 1
    for (int l = 0; l < NLAYER; ++l) {
#define WSP(off) (launder_p(a.ws) + (off))
        {
            unsigned char* w = launder_p(a.ws);
            pg8::Gemm g{(const bf16*)(w + WS_XB), (const bf16*)(w + WS_W + (size_t)l * LW + LW_IN), MTOK, NIN, DM}; pg8::StaticOrder S; S.init(MTOK, NIN, G, bx);
            pg8::EpiInProj E{(bf16*)(w + WS_PA), (bf16*)(w + WS_PZ), (bf16*)(w + WS_PS), (float*)(w + WS_BG), (const float*)(w + WS_SSP1), INP(4) + l * 4, INP(5) + l * 4};
            for (int rep = 0; rep < PROBE_G1; ++rep)
            pg8::gemm_phase<pg8::EpiInProj, pg8::StaticOrder, true, true>(lds, g, S, E, tid);
        }
        GRID_BAR();
        {
            unsigned char* w = launder_p(a.ws);
            const float* cwp = INP(3) + (size_t)l * 4 * 1536;
            {
                const int t3 = launder_v(tid);
                for (int i = t3; i < 4 * 4 * 384; i += 512) { const int hh = i / 1536, r2 = i % 1536, tap = r2 / 384, c2 = r2 % 384, s2 = c2 >> 7, ch = c2 & 127;
                    ((LAS float*)(lds + M1_CW))[i] = cwp[tap * 1536 + s2 * 512 + hh * 128 + ch]; }
                __syncthreads();
            }
            for (int rep = 0; rep < PROBE_M1; ++rep)
            for (int u = bx; u < 4096; u += G) m1_unit(lds, u, (const bf16*)(w + WS_PA), (const float*)(w + WS_BG), cwp, w + WS_INTER, (float*)(w + WS_SS), tid);
        }
        GRID_BAR();
        for (int rep = 0; rep < PROBE_SCAN; ++rep)
        for (int su = bx; su < 128; su += G) { unsigned char* w = launder_p(a.ws); const int xcd = su & 7, kk = su >> 3; scan_unit(lds, xcd * 4 + (kk >> 2), kk & 3, w + WS_INTER, (const float*)(w + WS_SS), (bf16*)(w + WS_MIX), launder_v(tid)); }
        {
            LAS unsigned* sh = (LAS unsigned*)(lds + 131072);
            unsigned char* w = launder_p(a.ws); unsigned* ctl = (unsigned*)(w + WS_CTL); const bf16* PS = (const bf16*)(w + WS_PS); bf16* MIX = (bf16*)(w + WS_MIX);
            const float* scw = INP(7) + (size_t)l * 3 * 512; const float* scg = INP(8) + (size_t)l * 512;
            for (;;) {
                if (tid == 0) sh[0] = atomicAdd(ctl + 64 * l, 1u);
                LDS_BAR();
                const unsigned c = sh[0];
                LDS_BAR();
                if (c >= 1024u) break;
                sc_chunk((int)c, PS, scw, scg, MIX, launder_v(tid));
            }
        }
        GRID_BAR();
        {
            unsigned char* w = launder_p(a.ws); bf16* MIX = (bf16*)(w + WS_MIX); const bf16* PZ = (const bf16*)(w + WS_PZ);
            const int tid5 = launder_v(tid), G5 = launder_i(G); const float* gn = INP(6) + l * 128; const int jj = tid5 & 15; const f32x4 g0 = *(const f32x4*)(gn + 8 * jj), g1 = *(const f32x4*)(gn + 8 * jj + 4);
            const int istride = (G5 * 512) >> 4;
#pragma unroll 1
            for (int item0 = (bx * 512 + tid5) >> 4; item0 < MTOK * 4; item0 += 4 * istride) {
                u32x4 ov[4], zv[4];
#pragma unroll
                for (int q = 0; q < 4; ++q) { const int item = item0 + q * istride, it2 = item < MTOK * 4 ? item : item0, token = it2 >> 2, hd = it2 & 3;
                    ov[q] = *(const u32x4*)(MIX + (size_t)token * 1024 + hd * 128 + 8 * jj); zv[q] = *(const u32x4*)(PZ + (size_t)token * 512 + hd * 128 + 8 * jj); }
#pragma unroll
                for (int q = 0; q < 4; ++q) { const int item = item0 + q * istride; if (item < MTOK * 4) { const int token = item >> 2, hd = item & 3;
                    float o[8] = {bflo(ov[q].x), bfhi(ov[q].x), bflo(ov[q].y), bfhi(ov[q].y), bflo(ov[q].z), bfhi(ov[q].z), bflo(ov[q].w), bfhi(ov[q].w)};
                    float z[8] = {bflo(zv[q].x), bfhi(zv[q].x), bflo(zv[q].y), bfhi(zv[q].y), bflo(zv[q].z), bfhi(zv[q].z), bflo(zv[q].w), bfhi(zv[q].w)};
                    float ssq = 0.f;
#pragma unroll
                    for (int e = 0; e < 8; ++e) ssq += o[e] * o[e];
                    ssq = sum16(ssq);
                    const float rn = rsqrtf(ssq * (1.0f / 128.0f) + 1e-6f);
                    const float gg[8] = {g0.x, g0.y, g0.z, g0.w, g1.x, g1.y, g1.z, g1.w};
#pragma unroll
                    for (int e = 0; e < 8; ++e) o[e] = o[e] * rn * gg[e] * (z[e] * __builtin_amdgcn_rcpf(1.0f + __expf(-z[e])));
                    u32x4 w; w.x = pk_bf16(o[0], o[1]); w.y = pk_bf16(o[2], o[3]); w.z = pk_bf16(o[4], o[5]); w.w = pk_bf16(o[6], o[7]);
                    *(u32x4*)(MIX + (size_t)token * 1024 + hd * 128 + 8 * jj) = w; } }
            }
        }
        GRID_BAR();
        {
            unsigned char* w = launder_p(a.ws);
            pg8::Gemm g{(const bf16*)(w + WS_MIX), (const bf16*)(w + WS_W + (size_t)l * LW + LW_OUT), MTOK, DM, DM}; pg8::StaticOrder S; S.init(MTOK, DM, G, bx);
            pg8::EpiResid E{(bf16*)(w + WS_XB), (float*)(w + WS_SSP2)};
            pg8::gemm_phase<pg8::EpiResid, pg8::StaticOrder, true, true>(lds, g, S, E, tid);
        }
        GRID_BAR();
        {
            unsigned char* w = launder_p(a.ws);
            pg8::Gemm g{(const bf16*)(w + WS_XB), (const bf16*)(w + WS_W + (size_t)l * LW + LW_GU), MTOK, NGU, DM}; pg8::StaticOrder S; S.init(MTOK, NGU, G, bx);
            pg8::EpiSwiGLU E{(bf16*)(w + WS_ACT), (const float*)(w + WS_SSP2)};
            for (int rep = 0; rep < PROBE_G3; ++rep)
            pg8::gemm_phase<pg8::EpiSwiGLU, pg8::StaticOrder, true, true>(lds, g, S, E, tid);
        }
        GRID_BAR();
        {
            unsigned char* w = launder_p(a.ws);
            pg8::Gemm g{(const bf16*)(w + WS_ACT), (const bf16*)(w + WS_W + (size_t)l * LW + LW_DN), MTOK, DM, FF}; pg8::StaticOrder S; S.init(MTOK, DM, G, bx);
            pg8::EpiResid E{(bf16*)(w + WS_XB), (float*)(w + WS_SSP1)};
            pg8::gemm_phase<pg8::EpiResid, pg8::StaticOrder, true, true>(lds, g, S, E, tid);
        }
        GRID_BAR();
    }
    {
        unsigned char* w = launder_p(a.ws); float* X = (float*)launder_p((unsigned char*)a.out); const float* SS1 = (const float*)(w + WS_SSP1);
        const int tidf = launder_v(tid), lane = tidf & 63;
        const float* gf = INP(14); const int gw = bx * 8 + (tidf >> 6), NGW = G * 8;
        f32x4 gv[4];
#pragma unroll
        for (int j = 0; j < 4; ++j) gv[j] = ((const f32x4*)gf)[lane + 64 * j];
        const bf16* XBf = (const bf16*)(w + WS_XB);
        for (int m = gw; m < MTOK; m += 2 * NGW) {
            const int m2 = m + NGW < MTOK ? m + NGW : m;
            const u32x2* xbr = (const u32x2*)(XBf + (size_t)m * DM) + lane; const u32x2* xbr2 = (const u32x2*)(XBf + (size_t)m2 * DM) + lane;
            u32x2 p[4], p2[4];
#pragma unroll
            for (int j = 0; j < 4; ++j) { p[j] = xbr[64 * j]; p2[j] = xbr2[64 * j]; }
            const float rn = pg8::row_rs(SS1, m), rn2 = pg8::row_rs(SS1, m2);
            f32x4* xr = (f32x4*)(X + (size_t)m * DM) + lane; f32x4* xr2 = (f32x4*)(X + (size_t)m2 * DM) + lane;
#pragma unroll
            for (int j = 0; j < 4; ++j) { f32x4 v = {bflo(p[j].x), bfhi(p[j].x), bflo(p[j].y), bfhi(p[j].y)}; v = v * rn * gv[j]; xr[64 * j] = v; }
            if (m2 != m) {
#pragma unroll
                for (int j = 0; j < 4; ++j) { f32x4 v = {bflo(p2[j].x), bfhi(p2[j].x), bflo(p2[j].y), bfhi(p2[j].y)}; v = v * rn2 * gv[j]; xr2[64 * j] = v; }
            }
        }
    }
}

extern "C" void kernel_launch(void* const* d_in, const int* in_sizes, int n_in, void* d_out, int out_size, void* d_ws, size_t ws_size, hipStream_t stream) {
    static int grid_blocks = 0;
    if (grid_blocks == 0) {
        if (n_in != 15 || in_sizes[0] != MTOK * DM || out_size != MTOK * DM || ws_size < WS_END) { fprintf(stderr, "kernel_launch: unexpected shapes (n_in %d, in0 %d, out %d, ws %zu)\n", n_in, n_in > 0 ? in_sizes[0] : -1, out_size, ws_size); grid_blocks = -1; return; }
        int dev = 0, cus = 0, per_cu = 0;
        hipGetDevice(&dev); hipDeviceGetAttribute(&cus, hipDeviceAttributeMultiprocessorCount, dev);
        if (hipFuncSetAttribute((const void*)hybrid_fwd, hipFuncAttributeMaxDynamicSharedMemorySize, LDS_BYTES) != hipSuccess) { fprintf(stderr, "kernel_launch: hipFuncSetAttribute failed\n"); grid_blocks = -1; return; }
        if (hipOccupancyMaxActiveBlocksPerMultiprocessor(&per_cu, (const void*)hybrid_fwd, 512, LDS_BYTES) != hipSuccess || per_cu < 1) { fprintf(stderr, "kernel_launch: occupancy query gave %d\n", per_cu); per_cu = 1; }
        (void)hipGetLastError();
        grid_blocks = cus * 1;
        fprintf(stderr, "kernel_launch: cus %d per_cu %d grid %d\n", cus, per_cu, grid_blocks);
    }
    if (grid_blocks < 0) return;
    hipMemsetAsync((char*)d_ws + WS_CTL, 0, 4096 + 16384, stream);
    Args a{};
    for (int i = 0; i < 15; ++i) a.in[i] = (const float*)d_in[i];
    a.out = (float*)d_out; a.ws = (unsigned char*)d_ws;
    void* args[] = {&a};
    hipError_t e = hipLaunchCooperativeKernel((const void*)hybrid_fwd, dim3(grid_blocks), dim3(512), args, LDS_BYTES, stream);
    if (e != hipSuccess) fprintf(stderr, "cooperative launch failed: %s (grid %d)\n", hipGetErrorString(e), grid_blocks);
}
```

```cpp
#include <hip/hip_runtime.h>
#include <hip/hip_cooperative_groups.h>
#include <cstdio>
#include <cstdint>
namespace cg = cooperative_groups;
namespace pg8 {
#define PG8_LAS __attribute__((address_space(3)))
typedef unsigned short bf16_t;
typedef short bf16x8 __attribute__((ext_vector_type(8)));
typedef float f32x4 __attribute__((ext_vector_type(4)));
typedef unsigned u32x4 __attribute__((ext_vector_type(4)));
constexpr int BM = 256, BK = 64, HALF = 128, HTB = HALF * BK * 2  , STAGE_BYTES = 8 * HTB, NXCD = 8, WGM = 8;

__host__ __device__ __forceinline__ int lds_byte(int r, int c) { const int st = (r >> 4) * 2 + (c >> 5), rr = r & 15, cc = c & 31, ob = rr * 64 + cc * 2; return st * 1024 + (ob ^ (((ob >> 9) & 1) << 5)); }
__host__ __device__ __forceinline__ void stage_rc(int b, int& R, int& C) { const int st = b / 1024, sb = b % 1024, swz = sb ^ (((sb >> 9) & 1) << 5); R = (st >> 1) * 16 + swz / 64; C = (st & 1) * 32 + (swz % 64) / 2; }
__host__ __device__ __forceinline__ int perm32(int rho) { const int n = rho >> 4, i = rho & 15; return 8 * (i >> 2) + 4 * n + (i & 3); }

struct Unit { int pm, pn; };
struct Gemm { const bf16_t* A; const bf16_t* Bt; int M, N, K; };

struct StaticOrder {
    int nM, nN, nwg, G, c;
    __host__ __device__ void init(int M, int N, int G_, int c_) { nM = M / BM; nN = N / BM; nwg = nM * nN; G = G_; c = c_; }
    __host__ __device__ bool next(int i, Unit& u) const {
        const long L = (long)i * G + c; if (L >= nwg) return false;
        int wgid = (int)L; { const int q = nwg / NXCD, r = nwg % NXCD, xcd = wgid % NXCD, off = wgid / NXCD; wgid = (xcd < r ? xcd * (q + 1) : r * (q + 1) + (xcd - r) * q) + off; }
        const int nig = WGM * nN, gid = wgid / nig, fm = gid * WGM, gsz = (nM - fm) < WGM ? (nM - fm) : WGM;
        u.pm = fm + ((wgid % nig) % gsz); u.pn = (wgid % nig) / gsz; return true;
    }
    __device__ __forceinline__ void a_ready(const Unit&) const {}
    __device__ __forceinline__ void done(const Unit&) const {}
};

typedef float f32x2 __attribute__((ext_vector_type(2)));
typedef __bf16 bf16x2_t __attribute__((ext_vector_type(2)));
__device__ __forceinline__ unsigned pk_bf16(float lo, float hi) { f32x2 v = {lo, hi}; bf16x2_t b = __builtin_convertvector(v, bf16x2_t); return __builtin_bit_cast(unsigned, b); }
__device__ __forceinline__ float sigmoid_f(float x) { return __builtin_amdgcn_rcpf(1.0f + __expf(-x)); }
__device__ __forceinline__ float row_rs(const float* ssp, int row) {
    const f32x4* p = (const f32x4*)(ssp + (size_t)row * 16); const f32x4 a = p[0], b = p[1], c = p[2], d = p[3];
    const float s = (((a.x + a.y) + (a.z + a.w)) + ((b.x + b.y) + (b.z + b.w))) + (((c.x + c.y) + (c.z + c.w)) + ((d.x + d.y) + (d.z + d.w)));
    return rsqrtf(s * (1.0f / 1024.0f) + 1e-6f);
}

__device__ __forceinline__ void row_rs8(const float* ssp, int row0, int fq, float (&rr)[8]) {
    f32x4 pv[8];
#pragma unroll
    for (int k = 0; k < 8; ++k) pv[k] = *(const __attribute__((address_space(1))) f32x4*)(ssp + (size_t)(row0 + (k >> 2) * HALF + (k & 3) * 16) * 16 + 4 * fq);
#pragma unroll
    for (int k = 0; k < 8; ++k) { float s = (pv[k].x + pv[k].y) + (pv[k].z + pv[k].w); s += __shfl_xor(s, 16); s += __shfl_xor(s, 32); rr[k] = rsqrtf(s * (1.0f / 1024.0f) + 1e-6f); }
}

struct EpiInProj {
    static constexpr bool PERM = true, AFTER_DRAIN = false;
    bf16_t* PA; bf16_t* PZ; bf16_t* PS; float* BG; const float* ss; const float* a_log; const float* dt_bias;
    __device__ __forceinline__ void operator()(const f32x4 (&acc)[2][2][4][2], const Unit& u, int wr, int wc, int fr, int fq) const {
        const int row0 = u.pm * BM + wr * 64 + fr;
        float rr[8]; row_rs8(ss, row0, fq, rr);
        if (u.pn < 14) {
            bf16_t* base; int ldc, colt;
            if (u.pn < 6) { base = PA; ldc = 1536; colt = u.pn * 256; }
            else if (u.pn < 8) { base = PZ; ldc = 512; colt = (u.pn - 6) * 256; }
            else { base = PS; ldc = 1536; colt = (u.pn - 8) * 256; }
            const int col0 = colt + wc * 32 + 8 * fq;
#pragma unroll
            for (int ai = 0; ai < 2; ++ai)
#pragma unroll
                for (int m = 0; m < 4; ++m) {
                    const int row = row0 + ai * HALF + m * 16;
                    const float r = rr[ai * 4 + m];
                    bf16_t* rowp = base + (size_t)row * ldc + col0;
#pragma unroll
                    for (int bj = 0; bj < 2; ++bj) {
                        const f32x4 v0 = acc[ai][bj][m][0] * r, v1 = acc[ai][bj][m][1] * r;
                        u32x4 w; w.x = pk_bf16(v0[0], v0[1]); w.y = pk_bf16(v0[2], v0[3]); w.z = pk_bf16(v1[0], v1[1]); w.w = pk_bf16(v1[2], v1[3]);
                        *(__attribute__((address_space(1))) u32x4*)(rowp + bj * HALF) = w;
                    }
                }
        } else if (wc == 0) {
            if (fq == 0) {
                const f32x4 al = *(const f32x4*)a_log, db = *(const f32x4*)dt_bias;
                const f32x4 ea = {__expf(al[0]), __expf(al[1]), __expf(al[2]), __expf(al[3])};
#pragma unroll
                for (int ai = 0; ai < 2; ++ai)
#pragma unroll
                    for (int m = 0; m < 4; ++m) {
                        const int row = row0 + ai * HALF + m * 16;
                        const float r = rr[ai * 4 + m];
                        const f32x4 bi = acc[ai][0][m][0] * r, av = acc[ai][0][m][1] * r;
                        f32x4 be, gg;
#pragma unroll
                        for (int h = 0; h < 4; ++h) {
                            be[h] = __builtin_amdgcn_rcpf(1.0f + __expf(-bi[h]));
                            const float xx = av[h] + db[h], ee = __expf(xx);
                            const float sp = xx > 20.f ? xx : (ee < 0.03f ? ee * (1.0f - ee * (0.5f - ee * (0.33333334f - 0.25f * ee))) : __logf(1.0f + ee));
                            gg[h] = -ea[h] * sp;
                        }
                        *(__attribute__((address_space(1))) f32x4*)(BG + (size_t)row * 8) = be; *(__attribute__((address_space(1))) f32x4*)(BG + (size_t)row * 8 + 4) = gg;
                    }
            }
        }
    }
};

struct EpiResid {
    static constexpr bool PERM = true, AFTER_DRAIN = false;
    bf16_t* xb; float* ss;
    __device__ __forceinline__ void operator()(const f32x4 (&acc)[2][2][4][2], const Unit& u, int wr, int wc, int fr, int fq) const {
        const int row0 = u.pm * BM + wr * 64 + fr, col0 = u.pn * BM + wc * 32 + 8 * fq;
        u32x4 xin[8][2];
#pragma unroll
        for (int k = 0; k < 8; ++k)
#pragma unroll
            for (int bj = 0; bj < 2; ++bj) xin[k][bj] = *(const __attribute__((address_space(1))) u32x4*)(xb + (size_t)(row0 + (k >> 2) * HALF + (k & 3) * 16) * 1024 + col0 + bj * HALF);
#pragma unroll
        for (int ai = 0; ai < 2; ++ai)
#pragma unroll
            for (int m = 0; m < 4; ++m) {
                const int row = row0 + ai * HALF + m * 16; const size_t off = (size_t)row * 1024 + col0;
                float sq = 0.f;
#pragma unroll
                for (int bj = 0; bj < 2; ++bj) {
                    const u32x4 xv = xin[ai * 4 + m][bj];
                    const f32x4 a0 = acc[ai][bj][m][0], a1 = acc[ai][bj][m][1];
                    u32x4 w;
                    w.x = pk_bf16(__uint_as_float(xv.x << 16) + a0[0], __uint_as_float(xv.x & 0xffff0000u) + a0[1]);
                    w.y = pk_bf16(__uint_as_float(xv.y << 16) + a0[2], __uint_as_float(xv.y & 0xffff0000u) + a0[3]);
                    w.z = pk_bf16(__uint_as_float(xv.z << 16) + a1[0], __uint_as_float(xv.z & 0xffff0000u) + a1[1]);
                    w.w = pk_bf16(__uint_as_float(xv.w << 16) + a1[2], __uint_as_float(xv.w & 0xffff0000u) + a1[3]);
                    *(__attribute__((address_space(1))) u32x4*)(xb + off + bj * HALF) = w;
                    const float r0 = __uint_as_float(w.x << 16), r1 = __uint_as_float(w.x & 0xffff0000u), r2 = __uint_as_float(w.y << 16), r3 = __uint_as_float(w.y & 0xffff0000u);
                    const float r4 = __uint_as_float(w.z << 16), r5 = __uint_as_float(w.z & 0xffff0000u), r6 = __uint_as_float(w.w << 16), r7 = __uint_as_float(w.w & 0xffff0000u);
                    sq += ((r0 * r0 + r1 * r1) + (r2 * r2 + r3 * r3)) + ((r4 * r4 + r5 * r5) + (r6 * r6 + r7 * r7));
                }
                sq += __shfl_xor(sq, 16); sq += __shfl_xor(sq, 32);
                if (fq == 0) *(__attribute__((address_space(1))) float*)(ss + (size_t)row * 16 + u.pn * 4 + wc) = sq;
                asm volatile("" ::: "memory");
            }
    }
};

struct EpiSwiGLU {
    static constexpr bool PERM = true, AFTER_DRAIN = false;
    bf16_t* act; const float* ss;
    __device__ __forceinline__ void operator()(const f32x4 (&acc)[2][2][4][2], const Unit& u, int wr, int wc, int fr, int fq) const {
        const int row0 = u.pm * BM + wr * 64 + fr, col0 = u.pn * HALF + wc * 32 + 8 * fq;
        float rr[8]; row_rs8(ss, row0, fq, rr);
#pragma unroll
        for (int ai = 0; ai < 2; ++ai)
#pragma unroll
            for (int m = 0; m < 4; ++m) {
                const int row = row0 + ai * HALF + m * 16;
                const float r = rr[ai * 4 + m];
                float o[8];
#pragma unroll
                for (int n = 0; n < 2; ++n)
#pragma unroll
                    for (int j = 0; j < 4; ++j) { const float g = acc[ai][0][m][n][j] * r, up = acc[ai][1][m][n][j] * r; o[n * 4 + j] = g * sigmoid_f(g) * up; }
                u32x4 w; w.x = pk_bf16(o[0], o[1]); w.y = pk_bf16(o[2], o[3]); w.z = pk_bf16(o[4], o[5]); w.w = pk_bf16(o[6], o[7]);
                *(__attribute__((address_space(1))) u32x4*)(act + (size_t)row * 2816 + col0) = w;
            }
    }
};

template <class Epi, class Sched, bool ALIGN_EPI = false, bool SP2 = false>
__device__ __forceinline__ void gemm_phase(PG8_LAS unsigned char* lds, const Gemm g, const Sched& S, const Epi& E, int tid_arg) {
    int tid_l = tid_arg; asm volatile("" : "+v"(tid_l));
    const int tid = tid_l, wid = __builtin_amdgcn_readfirstlane(tid >> 6), lane = tid & 63, wr = wid >> 2, wc = wid & 3, fr = lane & 15, fq = lane >> 4;
    const int K = g.K, nt = K / BK;
    unsigned voffA[2], voffB[2];
#pragma unroll
    for (int i = 0; i < 2; ++i) { int R, C; stage_rc(tid * 16 + i * 8192, R, C); const int Rb = Epi::PERM ? ((R & ~31) + perm32(R & 31)) : R;
        voffA[i] = (unsigned)(R * K + C) * 2u; voffB[i] = (unsigned)(Rb * K + C) * 2u; }
    const size_t kstep = (size_t)(BK * 2);
    const size_t hstep = (size_t)HALF * K * 2;
    const size_t tstep = 2 * hstep;
    const unsigned ldsw = (unsigned)wid * 1024u;
    const int aoff = lds_byte(wr * 64 + fr, fq * 8), boff = lds_byte(wc * 32 + fr, fq * 8);
#define PG8_SA(b, h) (((b) * 2 + (h)) * HTB)
#define PG8_SB(b, h) ((4 + (b) * 2 + (h)) * HTB)
#define PG8_STAGE(bufoff, gbase, voff) do { _Pragma("unroll") for (int _i = 0; _i < 2; ++_i) \
        __builtin_amdgcn_global_load_lds((const unsigned*)((const char*)(gbase) + (voff)[_i]), (PG8_LAS unsigned*)(lds + (bufoff) + ldsw + _i * 8192), 16, 0, 0); } while (0)
#define PG8_LDA(dst, b, h) do { _Pragma("unroll") for (int m = 0; m < 4; ++m) _Pragma("unroll") for (int k = 0; k < 2; ++k) dst[m][k] = *(const PG8_LAS bf16x8*)(lds + PG8_SA(b, h) + aoff + m * 2048 + k * 1024); } while (0)
#define PG8_LDB(dst, b, h) do { _Pragma("unroll") for (int n = 0; n < 2; ++n) _Pragma("unroll") for (int k = 0; k < 2; ++k) dst[n][k] = *(const PG8_LAS bf16x8*)(lds + PG8_SB(b, h) + boff + n * 2048 + k * 1024); } while (0)
#define PG8_MMA(ai, bj, At, Bt) do { __builtin_amdgcn_s_setprio(1); _Pragma("unroll") for (int m = 0; m < 4; ++m) _Pragma("unroll") for (int n = 0; n < 2; ++n) _Pragma("unroll") for (int k = 0; k < 2; ++k) \
        acc[ai][bj][m][n] = __builtin_amdgcn_mfma_f32_16x16x32_bf16(Bt[n][k], At[m][k], acc[ai][bj][m][n], 0, 0, 0); __builtin_amdgcn_s_setprio(0); } while (0)
#define PG8_WAIT_V(n) asm volatile("s_waitcnt vmcnt(" #n ")" ::: "memory")
#define PG8_WAIT_L(n) asm volatile("s_waitcnt lgkmcnt(" #n ")" ::: "memory")
#define PG8_BAR __builtin_amdgcn_s_barrier()
#define PG8_SCHED __builtin_amdgcn_sched_barrier(0)
    Unit cur, nxt; int ui = 0;
    if (!S.next(0, cur)) return;
    f32x4 acc[2][2][4][2];
#pragma unroll
    for (int a = 0; a < 2; ++a)
#pragma unroll
        for (int b = 0; b < 2; ++b)
#pragma unroll
            for (int m = 0; m < 4; ++m)
#pragma unroll
                for (int n = 0; n < 2; ++n) acc[a][b][m][n] = (f32x4){0.f, 0.f, 0.f, 0.f};
    bf16x8 At[4][2], B0[2][2], B1[2][2];
    const char* cA = (const char*)g.A + (size_t)cur.pm * tstep; const char* cB = (const char*)g.Bt + (size_t)cur.pn * tstep;
    S.a_ready(cur);
    if constexpr (SP2) {
        PG8_STAGE(PG8_SB(0, 0), cB, voffB); PG8_STAGE(PG8_SB(0, 1), cB + hstep, voffB); PG8_STAGE(PG8_SA(0, 0), cA, voffA); PG8_STAGE(PG8_SA(0, 1), cA + hstep, voffA);
        if (wr == 1) PG8_BAR;
        PG8_WAIT_V(2); PG8_BAR;
        PG8_STAGE(PG8_SB(1, 0), cB + kstep, voffB); PG8_STAGE(PG8_SA(1, 0), cA + kstep, voffA); PG8_STAGE(PG8_SB(1, 1), cB + hstep + kstep, voffB);
        PG8_WAIT_V(6); PG8_BAR;
    } else {
        PG8_STAGE(PG8_SB(0, 0), cB, voffB); PG8_STAGE(PG8_SA(0, 0), cA, voffA); PG8_STAGE(PG8_SB(0, 1), cB + hstep, voffB); PG8_STAGE(PG8_SA(0, 1), cA + hstep, voffA);
        if (wr == 1) PG8_BAR;
        PG8_WAIT_V(4); PG8_BAR;
        PG8_STAGE(PG8_SB(1, 0), cB + kstep, voffB); PG8_STAGE(PG8_SA(1, 0), cA + kstep, voffA); PG8_STAGE(PG8_SB(1, 1), cB + hstep + kstep, voffB);
        PG8_WAIT_V(6); PG8_BAR;
    }
    for (;;) {
        const bool has_next = S.next(ui + 1, nxt);
        const char* nA = has_next ? (const char*)g.A + (size_t)nxt.pm * tstep : cA; const char* nB = has_next ? (const char*)g.Bt + (size_t)nxt.pn * tstep : cB;
        for (int t = 0; t < nt; t += 2) {
            const bool last = (t == nt - 2);
            const char* a1 = cA + (size_t)(t + 1) * kstep;
            const char* a2 = last ? nA : cA + (size_t)(t + 2) * kstep; const char* b2 = last ? nB : cB + (size_t)(t + 2) * kstep;
            const char* a3 = a2 + kstep; const char* b3 = b2 + kstep;
            if (last && has_next) S.a_ready(nxt);
            if constexpr (SP2) {
            PG8_LDB(B0, 0, 0); PG8_LDB(B1, 0, 1); PG8_SCHED; PG8_LDA(At, 0, 0); PG8_STAGE(PG8_SA(1, 1), a1 + hstep, voffA);
            PG8_WAIT_V(8); PG8_WAIT_L(0); PG8_BAR; PG8_MMA(0, 0, At, B0); PG8_MMA(0, 1, At, B1); PG8_BAR; PG8_SCHED;
            PG8_LDA(At, 0, 1); PG8_STAGE(PG8_SB(0, 0), b2, voffB); PG8_STAGE(PG8_SB(0, 1), b2 + hstep, voffB); PG8_STAGE(PG8_SA(0, 0), a2, voffA);
            PG8_WAIT_V(8); PG8_WAIT_L(0); PG8_BAR; PG8_MMA(1, 0, At, B0); PG8_MMA(1, 1, At, B1); PG8_BAR; PG8_SCHED;
            PG8_LDB(B0, 1, 0); PG8_LDB(B1, 1, 1); PG8_SCHED; PG8_LDA(At, 1, 0); PG8_STAGE(PG8_SA(0, 1), a2 + hstep, voffA);
            PG8_WAIT_V(8); PG8_WAIT_L(0); PG8_BAR; PG8_MMA(0, 0, At, B0); PG8_MMA(0, 1, At, B1); PG8_BAR; PG8_SCHED;
            PG8_LDA(At, 1, 1); PG8_STAGE(PG8_SB(1, 0), b3, voffB); PG8_STAGE(PG8_SB(1, 1), b3 + hstep, voffB); PG8_STAGE(PG8_SA(1, 0), a3, voffA);
            PG8_WAIT_V(8); PG8_WAIT_L(0); PG8_BAR; PG8_MMA(1, 0, At, B0); PG8_MMA(1, 1, At, B1); PG8_BAR; PG8_SCHED;
            } else {
            PG8_LDB(B0, 0, 0); PG8_SCHED; PG8_LDA(At, 0, 0); PG8_STAGE(PG8_SA(1, 1), a1 + hstep, voffA);
            PG8_WAIT_L(8); PG8_BAR; PG8_WAIT_L(0); PG8_MMA(0, 0, At, B0); PG8_BAR; PG8_SCHED;
            PG8_LDB(B1, 0, 1); PG8_STAGE(PG8_SB(0, 0), b2, voffB);
            PG8_BAR; PG8_WAIT_L(0); PG8_MMA(0, 1, At, B1); PG8_BAR;
            PG8_LDA(At, 0, 1); PG8_STAGE(PG8_SA(0, 0), a2, voffA);
            PG8_BAR; PG8_WAIT_L(0); PG8_MMA(1, 0, At, B0); PG8_BAR; PG8_SCHED;
            PG8_STAGE(PG8_SB(0, 1), b2 + hstep, voffB);
            PG8_WAIT_V(6); PG8_BAR; PG8_MMA(1, 1, At, B1); PG8_BAR;
            PG8_LDB(B0, 1, 0); PG8_SCHED; PG8_LDA(At, 1, 0); PG8_STAGE(PG8_SA(0, 1), a2 + hstep, voffA);
            PG8_WAIT_L(8); PG8_BAR; PG8_WAIT_L(0); PG8_MMA(0, 0, At, B0); PG8_BAR; PG8_SCHED;
            PG8_LDB(B1, 1, 1); PG8_STAGE(PG8_SB(1, 0), b3, voffB);
            PG8_BAR; PG8_WAIT_L(0); PG8_MMA(0, 1, At, B1); PG8_BAR;
            PG8_LDA(At, 1, 1); PG8_STAGE(PG8_SA(1, 0), a3, voffA);
            PG8_BAR; PG8_WAIT_L(0); PG8_MMA(1, 0, At, B0); PG8_BAR; PG8_SCHED;
            PG8_STAGE(PG8_SB(1, 1), b3 + hstep, voffB);
            PG8_WAIT_V(6); PG8_BAR; PG8_MMA(1, 1, At, B1); PG8_BAR;
            }
        }
        if constexpr (ALIGN_EPI) { if (wr == 0) PG8_BAR; }
        if constexpr (!Epi::AFTER_DRAIN) { E(acc, cur, wr, wc, fr, fq); S.done(cur); }
        if (!has_next) break;
#pragma unroll
        for (int a = 0; a < 2; ++a)
#pragma unroll
            for (int b = 0; b < 2; ++b)
#pragma unroll
                for (int m = 0; m < 4; ++m)
#pragma unroll
                    for (int n = 0; n < 2; ++n) acc[a][b][m][n] = (f32x4){0.f, 0.f, 0.f, 0.f};
        cur = nxt; cA = nA; cB = nB; ++ui;
        if constexpr (ALIGN_EPI) { if (wr == 1) PG8_BAR; }
    }
    PG8_WAIT_V(0);
    if constexpr (!ALIGN_EPI) { if (wr == 0) PG8_BAR; }
    PG8_BAR;
    if constexpr (Epi::AFTER_DRAIN) { E.fused(acc, cur, wr, wc, fr, fq, lds, wid, lane); S.done(cur); }
#undef PG8_SA
#undef PG8_SB
#undef PG8_STAGE
#undef PG8_LDA
#undef PG8_LDB
#undef PG8_MMA
#undef PG8_WAIT_V
#undef PG8_WAIT_L
#undef PG8_BAR
#undef PG8_SCHED
}
}

#define LAS __attribute__((address_space(3)))
typedef unsigned short bf16;
typedef unsigned u32x4 __attribute__((ext_vector_type(4)));
typedef unsigned u32x2 __attribute__((ext_vector_type(2)));
typedef float f32x4 __attribute__((ext_vector_type(4)));
typedef float f32x16 __attribute__((ext_vector_type(16)));
typedef short bf16x8 __attribute__((ext_vector_type(8)));
using pg8::pk_bf16;
#define MFMA32(a, b, c) __builtin_amdgcn_mfma_f32_32x32x16_bf16((a), (b), (c), 0, 0, 0)

#ifndef PROBE_M1
#define PROBE_M1 1
#endif
#ifndef PROBE_SCAN
#define PROBE_SCAN 1
#endif
#ifndef PROBE_G1
#define PROBE_G1 1
#endif
#ifndef PROBE_G3
#define PROBE_G3 1
#endif
constexpr int MTOK = 65536, DM = 1024, NLAYER = 4, TSEQ = 8192, FF = 2816, NIN = 3840, NGU = 5632;
constexpr size_t MiB = (size_t)1 << 20;
constexpr size_t WS_CTL = 0, WS_W = 1 * MiB, LW = 27262976, LW_IN = 0, LW_OUT = 7864320, LW_GU = 9961472, LW_DN = 21495808;
constexpr size_t WS_XB = 105 * MiB, WS_SS = 233 * MiB, WS_BG = 234 * MiB, WS_PA = 236 * MiB, WS_MIX = 236 * MiB, WS_PZ = 428 * MiB, WS_PS = 492 * MiB, WS_INTER = 684 * MiB, WS_ACT = 236 * MiB, WS_SSP1 = 972 * MiB, WS_SSP2 = 976 * MiB, WS_END = 980 * MiB;
static_assert(WS_W + 4 * LW <= WS_XB, "weights fit");
constexpr int UNIT_BYTES = 73728;
constexpr int LDS_BYTES = 147456;
constexpr float QSCALE = 0.08838834764831845f;

__device__ __forceinline__ float bf2f(unsigned short v) { return __uint_as_float((unsigned)v << 16); }
__device__ __forceinline__ float bflo(unsigned w) { return __uint_as_float(w << 16); }
__device__ __forceinline__ float bfhi(unsigned w) { return __uint_as_float(w & 0xffff0000u); }
__device__ __forceinline__ unsigned short f2bf(float f) { return (unsigned short)(pk_bf16(f, 0.f) & 0xffffu); }
__device__ __forceinline__ float wave_sum(float v) {
#pragma unroll
    for (int o = 1; o < 64; o <<= 1) v += __shfl_xor(v, o);
    return v;
}
__device__ __forceinline__ float sum16(float v) { v += __shfl_xor(v, 1); v += __shfl_xor(v, 2); v += __shfl_xor(v, 4); v += __shfl_xor(v, 8); return v; }
__device__ __forceinline__ constexpr int crow(int reg, int h) { return (reg & 3) + 8 * (reg >> 2) + 4 * h; }
__device__ __forceinline__ bf16x8 pack_step(const f32x16& x, int s) {
    u32x4 p; p.x = pk_bf16(x[8 * s], x[8 * s + 1]); p.y = pk_bf16(x[8 * s + 2], x[8 * s + 3]); p.z = pk_bf16(x[8 * s + 4], x[8 * s + 5]); p.w = pk_bf16(x[8 * s + 6], x[8 * s + 7]);
    return __builtin_bit_cast(bf16x8, p);
}
#define LDS_WAIT() asm volatile("s_waitcnt lgkmcnt(0)" ::: "memory")
#define LDS_BAR() do { asm volatile("s_waitcnt lgkmcnt(0)" ::: "memory"); __builtin_amdgcn_s_barrier(); asm volatile("" ::: "memory"); } while (0)
__device__ __forceinline__ unsigned char* launder_p(unsigned char* p) { asm volatile("" : "+s"(p)); return p; }
__device__ __forceinline__ int launder_i(int i) { asm volatile("" : "+s"(i)); return i; }
#define INP(k) (a.in[launder_i(k)])
__device__ __forceinline__ int launder_v(int i) { asm volatile("" : "+v"(i)); return i; }
__device__ __forceinline__ int fresh_tid(int wave_s) { unsigned ones = ~0u; asm volatile("" : "+s"(ones)); return (wave_s << 6) | (int)__builtin_amdgcn_mbcnt_hi(ones, __builtin_amdgcn_mbcnt_lo(ones, 0u)); }

__device__ __forceinline__ void transpose_item(const float* W, int ldw, int sc, const float* gain, bf16* dst, int K, int k0, LAS float* scr, int lane) {
    float wv[32];
#pragma unroll
    for (int i = 0; i < 32; ++i) { const int kk = 2 * i + (lane >> 5); wv[i] = 0.f; if (sc >= 0) wv[i] = *(const __attribute__((address_space(1))) float*)(W + (size_t)(k0 + kk) * ldw + sc); }
#pragma unroll
    for (int i = 0; i < 32; ++i) { const int kk = 2 * i + (lane >> 5); float v = wv[i]; if (gain) v *= gain[k0 + kk]; scr[kk * 33 + (lane & 31)] = v; }
    LDS_WAIT(); asm volatile("" ::: "memory");
    const int c = lane & 7;
#pragma unroll
    for (int j = 0; j < 4; ++j) { const int n = (lane >> 3) + 8 * j; const LAS float* s = scr + (8 * c) * 33 + n;
        u32x4 o; o.x = pk_bf16(s[0 * 33], s[1 * 33]); o.y = pk_bf16(s[2 * 33], s[3 * 33]); o.z = pk_bf16(s[4 * 33], s[5 * 33]); o.w = pk_bf16(s[6 * 33], s[7 * 33]);
        *(u32x4*)(dst + (size_t)n * K + k0 + 8 * c) = o; }
    LDS_WAIT(); asm volatile("" ::: "memory");
}

struct Args { const float* in[15]; float* out; unsigned char* ws; };

__device__ __forceinline__ void p0_prologue(const Args& a, LAS unsigned char* lds, int G, int bx, int tid) {
    const int lane = tid & 63, wave = tid >> 6;
    LAS float* scr = (LAS float*)(lds + wave * 16384);
    const int gw = bx * 8 + wave, NGW = G * 8;
    constexpr int I_IN = 16 * 120, I_OUT = 16 * 32, I_GU = 16 * 176, I_DN = 44 * 32, LI = I_IN + I_OUT + I_GU + I_DN;
    unsigned char* wsw = launder_p(a.ws) + WS_W;
    for (int it = gw; it < NLAYER * LI; it += NGW) {
        const int l = it / LI; int r = it % LI; const int cl = lane & 31;
        unsigned char* wl = wsw + (size_t)l * LW;
        if (r < I_IN) { const int kb = r / 120, nb = r % 120, n = nb * 32 + cl;
            const int sc = n < 2048 ? n : (n < 3584 ? n + 8 : (n < 3592 ? n - 3584 + 2048 : -1));
            transpose_item(a.in[2] + (size_t)l * 1024 * 3592, 3592, sc, a.in[1] + l * 1024, (bf16*)(wl + LW_IN) + (size_t)nb * 32 * 1024, 1024, kb * 64, scr, lane); continue; }
        r -= I_IN;
        if (r < I_OUT) { const int kb = r / 32, nb = r % 32;
            transpose_item(a.in[9] + (size_t)l * 1024 * 1024, 1024, nb * 32 + cl, nullptr, (bf16*)(wl + LW_OUT) + (size_t)nb * 32 * 1024, 1024, kb * 64, scr, lane); continue; }
        r -= I_OUT;
        if (r < I_GU) { const int kb = r / 176, nb = r % 176, R0 = nb * 32, pn = R0 >> 8, rr = R0 & 255, bj = rr >> 7, j0 = rr & 127;
            const float* Wsrc = (bj ? a.in[12] : a.in[11]) + (size_t)l * 1024 * 2816;
            transpose_item(Wsrc, 2816, 128 * pn + j0 + cl, a.in[10] + l * 1024, (bf16*)(wl + LW_GU) + (size_t)R0 * 1024, 1024, kb * 64, scr, lane); continue; }
        r -= I_GU;
        { const int kb = r / 32, nb = r % 32;
            transpose_item(a.in[13] + (size_t)l * 2816 * 1024, 1024, nb * 32 + cl, nullptr, (bf16*)(wl + LW_DN) + (size_t)nb * 32 * 2816, 2816, kb * 64, scr, lane); }
    }
    const float* x = a.in[0]; bf16* XB = (bf16*)(a.ws + WS_XB); float* SS1 = (float*)(a.ws + WS_SSP1);
    for (int m = gw; m < MTOK; m += NGW) {
        const f32x4* xr = (const f32x4*)(x + (size_t)m * DM) + lane; f32x4 v[4]; float s = 0.f;
#pragma unroll
        for (int j = 0; j < 4; ++j) { v[j] = xr[64 * j]; s += (v[j].x * v[j].x + v[j].y * v[j].y) + (v[j].z * v[j].z + v[j].w * v[j].w); }
        s = wave_sum(s); if (lane < 16) SS1[(size_t)m * 16 + lane] = lane == 0 ? s : 0.f;
        u32x2* o8 = (u32x2*)(XB + (size_t)m * DM) + lane;
#pragma unroll
        for (int j = 0; j < 4; ++j) { u32x2 o; o.x = pk_bf16(v[j].x, v[j].y); o.y = pk_bf16(v[j].z, v[j].w); o8[64 * j] = o; }
    }
}

constexpr int M1_RAW = 0, M1_AMAT = 0, M1_QKM = 17408, M1_WS = 26624, M1_QS = 51712, M1_KS = 69120, M1_VS = 86528, M1_GC = 103936, M1_BETA = 104192, M1_EG = 104448, M1_BEG = 104704, M1_CW = 106496  , ROWB = 272;

typedef float f32x2v __attribute__((ext_vector_type(2)));
template <int C> struct SolveRows {
    static __device__ __forceinline__ void run(f32x2v (&X2)[32], f32x4 (&cur)[16], LAS unsigned char* lds, const LAS unsigned short* src, const LAS float* fac) {
        f32x4 nxt[16];
#pragma unroll
        for (int q = 0; q < 16; ++q) if (C + 1 < 64 && 4 * q < C + 1) nxt[q] = *(const LAS f32x4*)(lds + M1_AMAT + ((C + 1) * 68 + 4 * q) * 4);
        const float rhs = bf2f(src[C * 136]) * fac[C];
        f32x2v acc0 = {0.f, 0.f}, acc1 = {0.f, 0.f}, acc2 = {0.f, 0.f}, acc3 = {0.f, 0.f};
#pragma unroll
        for (int q = 0; q < 16; ++q) if (4 * q < C) { const f32x4 av = cur[q];
            if (q & 1) { acc2 -= (f32x2v){av.x, av.y} * X2[2 * q]; if (4 * q + 2 < C) acc3 -= (f32x2v){av.z, av.w} * X2[2 * q + 1]; }
            else { acc0 -= (f32x2v){av.x, av.y} * X2[2 * q]; if (4 * q + 2 < C) acc1 -= (f32x2v){av.z, av.w} * X2[2 * q + 1]; } }
        acc0 += acc1; acc2 += acc3; acc0 += acc2;
        float xc = rhs + (acc0.x + acc0.y);
        asm volatile("" : "+v"(xc) :: "memory");
        X2[C >> 1][C & 1] = xc;
#pragma unroll
        for (int q = 0; q < 16; ++q) if (C + 1 < 64 && 4 * q < C + 1) cur[q] = nxt[q];
        if constexpr (C + 1 < 64) SolveRows<C + 1>::run(X2, cur, lds, src, fac);
    }
};

__device__ __forceinline__ void m1_unit(LAS unsigned char* lds, int unit, const bf16* PA, const float* BG, const float* convw, unsigned char* inter, float* glast, int tid_in) {
    int tid = tid_in; asm volatile("" : "+v"(tid));
    const int b = unit >> 9, n = (unit >> 2) & 127, h = unit & 3;
    const int lane = tid & 63, wave = __builtin_amdgcn_readfirstlane(tid >> 6);
    const size_t row0 = (size_t)b * TSEQ + n * 64;
    LAS float* GC = (LAS float*)(lds + M1_GC); LAS float* BETA = (LAS float*)(lds + M1_BETA); LAS float* EG = (LAS float*)(lds + M1_EG); LAS float* BEG = (LAS float*)(lds + M1_BEG);
    unsigned char* ub = inter + (size_t)unit * UNIT_BYTES;
    float bt = 0.f, gv = 0.f;
    if (wave == 0) { const __attribute__((address_space(1))) float* bgp = (const __attribute__((address_space(1))) float*)(BG + (row0 + lane) * 8 + h); bt = bgp[0]; gv = bgp[4]; }
    {
        u32x4 rv[7];
#pragma unroll
        for (int it = 0; it < 7; ++it) {
            const int idx = tid + 512 * it, row = idx / 48, rem = idx % 48, seg = rem >> 4, part = rem & 15, t = n * 64 - 3 + row;
            rv[it] = (u32x4){0u, 0u, 0u, 0u};
            if (idx < 67 * 48 && t >= 0) rv[it] = *(const __attribute__((address_space(1))) u32x4*)(PA + ((size_t)b * TSEQ + t) * 1536 + seg * 512 + h * 128 + part * 8);
        }
#pragma unroll
        for (int it = 0; it < 7; ++it) {
            const int idx = tid + 512 * it, row = idx / 48, rem = idx % 48, seg = rem >> 4, part = rem & 15;
            if (idx < 67 * 48) *(LAS u32x4*)(lds + M1_RAW + row * 768 + seg * 256 + part * 16) = rv[it];
        }
    }
    if (wave == 0) {
#pragma unroll
        for (int off = 1; off < 64; off <<= 1) { const int srcl = lane >= off ? lane - off : lane; const float t = __int_as_float(__builtin_amdgcn_ds_bpermute(srcl << 2, __float_as_int(gv))); if (lane >= off) gv += t; }
        const float eg = __expf(gv);
        GC[lane] = gv; BETA[lane] = bt; EG[lane] = eg; BEG[lane] = bt * eg;
    }
    LDS_BAR();
    {
        const int j = tid & 15, cb = tid >> 4;
#pragma unroll 1
        for (int s = 0; s < 3; ++s) {
            float cw[4][8];
#pragma unroll
            for (int tap = 0; tap < 4; ++tap) { const LAS float* wp = (const LAS float*)(lds + M1_CW) + (h * 4 + tap) * 384 + s * 128 + 8 * j; const f32x4 w0 = *(const LAS f32x4*)wp, w1 = *(const LAS f32x4*)(wp + 4);
                cw[tap][0] = w0.x; cw[tap][1] = w0.y; cw[tap][2] = w0.z; cw[tap][3] = w0.w; cw[tap][4] = w1.x; cw[tap][5] = w1.y; cw[tap][6] = w1.z; cw[tap][7] = w1.w; }
            const int dstoff = s == 0 ? M1_QS : (s == 1 ? M1_KS : M1_VS);
#pragma unroll
            for (int pass = 0; pass < 2; ++pass) {
                const int c = cb + 32 * pass; float y[8];
#pragma unroll
                for (int e = 0; e < 8; ++e) y[e] = 0.f;
#pragma unroll
                for (int tap = 0; tap < 4; ++tap) { const u32x4 xv = *(const LAS u32x4*)(lds + M1_RAW + (c + tap) * 768 + s * 256 + j * 16);
                    y[0] += cw[tap][0] * bflo(xv.x); y[1] += cw[tap][1] * bfhi(xv.x); y[2] += cw[tap][2] * bflo(xv.y); y[3] += cw[tap][3] * bfhi(xv.y);
                    y[4] += cw[tap][4] * bflo(xv.z); y[5] += cw[tap][5] * bfhi(xv.z); y[6] += cw[tap][6] * bflo(xv.w); y[7] += cw[tap][7] * bfhi(xv.w); }
                float ssq = 0.f;
#pragma unroll
                for (int e = 0; e < 8; ++e) { y[e] = y[e] * __builtin_amdgcn_rcpf(1.0f + __expf(-y[e])); ssq += y[e] * y[e]; }
                ssq = sum16(ssq);
                const float rn = (s < 2) ? rsqrtf(ssq + 1e-6f) : 1.0f;
                u32x4 o; o.x = pk_bf16(y[0] * rn, y[1] * rn); o.y = pk_bf16(y[2] * rn, y[3] * rn); o.z = pk_bf16(y[4] * rn, y[5] * rn); o.w = pk_bf16(y[6] * rn, y[7] * rn);
                *(LAS u32x4*)(lds + dstoff + c * ROWB + j * 16) = o;
            }
        }
    }
    LDS_BAR();
    {
        const int r = lane & 31, hh = lane >> 5, w4 = wave & 3, ti = w4 >> 1, tj = w4 & 1; const bool isqk = wave >= 4, upper = (ti == 0 && tj == 1);
        if (isqk || !upper) {
            f32x16 x;
#pragma unroll
            for (int i = 0; i < 16; ++i) x[i] = 0.f;
            if (!upper) {
                const LAS unsigned char* Ab = lds + (isqk ? M1_QS : M1_KS) + (32 * ti + r) * ROWB + hh * 16;
                const LAS unsigned char* Bb = lds + M1_KS + (32 * tj + r) * ROWB + hh * 16;
#pragma unroll
                for (int s = 0; s < 8; ++s) { const bf16x8 av = *(const LAS bf16x8*)(Ab + s * 32), bv = *(const LAS bf16x8*)(Bb + s * 32); x = MFMA32(av, bv, x); }
            }
            const int m = 32 * tj + r; const float gm = GC[m];
            float gcv[16], btv[16];
#pragma unroll
            for (int i = 0; i < 16; ++i) { const int c = 32 * ti + crow(i, hh); gcv[i] = GC[c]; btv[i] = BETA[c]; }
#pragma unroll
            for (int i = 0; i < 16; ++i) { const int c = 32 * ti + crow(i, hh); const float dec = __expf(gcv[i] - gm);
                if (!isqk) { const float val = (m < c) ? btv[i] * x[i] * dec : 0.f; *(LAS float*)(lds + M1_AMAT + (c * 68 + m) * 4) = val; }
                else { const float val = (m <= c) ? x[i] * QSCALE * dec : 0.f; *(LAS unsigned short*)(lds + M1_QKM + (c * 72 + m) * 2) = f2bf(val); } }
        }
    }
    LDS_BAR();
    asm volatile("" : "+v"(tid));
    f32x2v X2[32];
#pragma unroll
    for (int k = 0; k < 32; ++k) X2[k] = (f32x2v){0.f, 0.f};
#define X(i) (X2[(i) >> 1][(i) & 1])
    if (tid < 256) {
        unsigned srcoff = (tid < 128 ? M1_VS : M1_KS) + (tid & 127) * 2, facoff = tid < 128 ? M1_BETA : M1_BEG;
        asm volatile("" : "+v"(srcoff), "+v"(facoff));
        const LAS unsigned short* src = (const LAS unsigned short*)(lds + srcoff);
        const LAS float* fac = (const LAS float*)(lds + facoff);
        f32x4 cur[16];
        SolveRows<0>::run(X2, cur, lds, src, fac);
    } else {
        const int t2 = tid - 256; const float glc = GC[63];
#pragma unroll
        for (int it = 0; it < 4; ++it) {
            const int idx = t2 + 256 * it, frag = idx >> 6, l2 = idx & 63, tt = frag >> 2, ks = frag & 3, nn = l2 & 15, qq = l2 >> 4, c = 16 * tt + nn, dk0 = 32 * ks + 4 * qq;
            const u32x2 p0 = *(const LAS u32x2*)(lds + M1_QS + c * ROWB + dk0 * 2), p1 = *(const LAS u32x2*)(lds + M1_QS + c * ROWB + (dk0 + 16) * 2);
            const float f = QSCALE * EG[c];
            u32x4 o; o.x = pk_bf16(bflo(p0.x) * f, bfhi(p0.x) * f); o.y = pk_bf16(bflo(p0.y) * f, bfhi(p0.y) * f); o.z = pk_bf16(bflo(p1.x) * f, bfhi(p1.x) * f); o.w = pk_bf16(bflo(p1.y) * f, bfhi(p1.y) * f);
            *(__attribute__((address_space(1))) u32x4*)(ub + 16384 + idx * 16) = o;
        }
#pragma unroll
        for (int it = 0; it < 4; ++it) {
            const int idx = t2 + 256 * it, frag = idx >> 6, l2 = idx & 63, t8 = frag >> 1, ks = frag & 1, nn = l2 & 15, qq = l2 >> 4, dk = 16 * t8 + nn;
            float v[8];
#pragma unroll
            for (int e = 0; e < 8; ++e) { const int tok = 32 * ks + 16 * (e >> 2) + 4 * qq + (e & 3); v[e] = bf2f(*(const LAS unsigned short*)(lds + M1_KS + tok * ROWB + dk * 2)) * __expf(glc - GC[tok]); }
            u32x4 o; o.x = pk_bf16(v[0], v[1]); o.y = pk_bf16(v[2], v[3]); o.z = pk_bf16(v[4], v[5]); o.w = pk_bf16(v[6], v[7]);
            *(__attribute__((address_space(1))) u32x4*)(ub + 32768 + idx * 16) = o;
        }
#pragma unroll
        for (int it = 0; it < 2; ++it) {
            const int idx = t2 + 256 * it, frag = idx >> 6, l2 = idx & 63, tt = frag >> 1, ks = frag & 1, nn = l2 & 15, qq = l2 >> 4, c = 16 * tt + nn, m0 = 32 * ks + 4 * qq;
            const u32x2 p0 = *(const LAS u32x2*)(lds + M1_QKM + (c * 72 + m0) * 2), p1 = *(const LAS u32x2*)(lds + M1_QKM + (c * 72 + m0 + 16) * 2);
            u32x4 o; o.x = p0.x; o.y = p0.y; o.z = p1.x; o.w = p1.y;
            *(__attribute__((address_space(1))) u32x4*)(ub + 49152 + idx * 16) = o;
        }
    }
    LDS_BAR();
    asm volatile("" : "+v"(tid));
    if (tid < 128) {
        const int sl = tid >> 4, nn = tid & 15; unsigned char* ubU = ub + 57344 + sl * 2048;
#pragma unroll
        for (int qq = 0; qq < 4; ++qq) {
            u32x4 o0, o1;
            o0.x = pk_bf16(X(4 * qq), X(4 * qq + 1)); o0.y = pk_bf16(X(4 * qq + 2), X(4 * qq + 3)); o0.z = pk_bf16(X(16 + 4 * qq), X(16 + 4 * qq + 1)); o0.w = pk_bf16(X(16 + 4 * qq + 2), X(16 + 4 * qq + 3));
            o1.x = pk_bf16(X(32 + 4 * qq), X(32 + 4 * qq + 1)); o1.y = pk_bf16(X(32 + 4 * qq + 2), X(32 + 4 * qq + 3)); o1.z = pk_bf16(X(48 + 4 * qq), X(48 + 4 * qq + 1)); o1.w = pk_bf16(X(48 + 4 * qq + 2), X(48 + 4 * qq + 3));
            __attribute__((address_space(1))) u32x4* dst = (__attribute__((address_space(1))) u32x4*)(ubU + (qq * 16 + nn) * 32); dst[0] = o0; dst[1] = o1;
        }
    } else if (tid < 256) {
        const int d = tid - 128;
#pragma unroll
        for (int c = 0; c < 64; ++c) *(LAS unsigned short*)(lds + M1_WS + c * ROWB + d * 2) = f2bf(X(c));
    } else if (tid == 256) *(__attribute__((address_space(1))) float*)(glast + unit) = __expf(GC[63]);
    LDS_BAR();
    asm volatile("" : "+v"(tid));
#pragma unroll
    for (int it = 0; it < 2; ++it) {
        const int idx = tid + 512 * it, frag = idx >> 6, l2 = idx & 63, tt = frag >> 2, ks = frag & 3, nn = l2 & 15, qq = l2 >> 4, c = 16 * tt + nn, dk0 = 32 * ks + 4 * qq;
        const u32x2 p0 = *(const LAS u32x2*)(lds + M1_WS + c * ROWB + dk0 * 2), p1 = *(const LAS u32x2*)(lds + M1_WS + c * ROWB + (dk0 + 16) * 2);
        u32x4 o; o.x = p0.x; o.y = p0.y; o.z = p1.x; o.w = p1.y;
        *(__attribute__((address_space(1))) u32x4*)(ub + idx * 16) = o;
    }
    LDS_BAR();
#undef X
}

constexpr int SC_BUF = 61440, SC_CTL = 131072;
#define MFMA16(a, b, c) __builtin_amdgcn_mfma_f32_16x16x32_bf16((a), (b), (c), 0, 0, 0)
__device__ __forceinline__ bf16x8 pack4(const f32x4& a, const f32x4& b) { u32x4 p; p.x = pk_bf16(a[0], a[1]); p.y = pk_bf16(a[2], a[3]); p.z = pk_bf16(b[0], b[1]); p.w = pk_bf16(b[2], b[3]); return __builtin_bit_cast(bf16x8, p); }
__device__ __forceinline__ const unsigned char* scan_piece(const unsigned char* ub, int half, int p) { return ub + (p < 56 ? p * 1024 : 57344 + half * 4096 + (p - 56) * 1024); }
__device__ __forceinline__ void scan_issue(LAS unsigned char* lds, const unsigned char* ub, int half, int buf, int wave, int lane) {
#pragma unroll
    for (int k = 0; k < 8; ++k) { const int p = wave + 8 * k;
        if (p < 60) __builtin_amdgcn_global_load_lds((const unsigned*)(scan_piece(ub, half, p) + lane * 16), (LAS unsigned*)(lds + buf * SC_BUF + p * 1024), 16, 0, 0); }
}
__device__ __forceinline__ void scan_prefetch(LAS unsigned char* lds, const unsigned char* ub, int half, int wave, int lane) {
#pragma unroll
    for (int k = 0; k < 2; ++k) { const int g8 = (wave - 4) * 2 + k;
        const unsigned char* src = ub + (g8 < 7 ? g8 * 8192 : 57344 + half * 4096) + lane * 128;
        __builtin_amdgcn_global_load_lds((const unsigned*)src, (LAS unsigned*)(lds + SC_CTL + 2048 + wave * 1024), 4, 0, 0); }
}
#define FRAG(off) (*(const LAS bf16x8*)(L + (off) + lane * 16))
__device__ __forceinline__ void scan_unit(LAS unsigned char* lds, int bh, int half, const unsigned char* inter, const float* glast, bf16* MIX, int tid) {
    const int wave = __builtin_amdgcn_readfirstlane(tid >> 6), lane = tid & 63, b = bh >> 2, h = bh & 3, nn = lane & 15, qq = lane >> 4;
    f32x4 S[8];
#pragma unroll
    for (int d = 0; d < 8; ++d) S[d] = (f32x4){0.f, 0.f, 0.f, 0.f};
    const int unit0 = (b * 128) * 4 + h;
    LAS float* GLS = (LAS float*)(lds + SC_CTL + 256);
    if (tid < 128) GLS[tid] = glast[unit0 + 4 * tid];
    scan_issue(lds, inter + (size_t)unit0 * UNIT_BYTES, half, 0, wave, lane);
    if (false) { scan_prefetch(lds, inter + (size_t)(unit0 + 4) * UNIT_BYTES, half, wave, lane); scan_prefetch(lds, inter + (size_t)(unit0 + 8) * UNIT_BYTES, half, wave, lane); scan_prefetch(lds, inter + (size_t)(unit0 + 12) * UNIT_BYTES, half, wave, lane); }
    asm volatile("s_waitcnt vmcnt(0)" ::: "memory"); __syncthreads();
#pragma unroll 1
    for (int n = 0; n < 128; ++n) {
        const int buf = n & 1, unit = unit0 + n * 4;
        if (n + 1 < 128) scan_issue(lds, inter + (size_t)(unit + 4) * UNIT_BYTES, half, buf ^ 1, wave, lane);
        const bool pf = false;
        if (pf) scan_prefetch(lds, inter + (size_t)(unit + 16) * UNIT_BYTES, half, wave, lane);
        if (wave < 2) {
            const LAS unsigned char* L = lds + buf * SC_BUF;
            const float gl = GLS[n];
#define SB() __builtin_amdgcn_sched_barrier(0)
            bf16x8 R1[16], R2[16];
#pragma unroll
            for (int t = 0; t < 4; ++t) { R1[2 * t] = FRAG((4 * t) * 1024); R1[2 * t + 1] = FRAG((4 * t + 1) * 1024); R1[8 + 2 * t] = FRAG(16384 + (4 * t) * 1024); R1[8 + 2 * t + 1] = FRAG(16384 + (4 * t + 1) * 1024); }
#pragma unroll
            for (int t = 0; t < 4; ++t) { R2[2 * t] = FRAG((4 * t + 2) * 1024); R2[2 * t + 1] = FRAG((4 * t + 3) * 1024); R2[8 + 2 * t] = FRAG(16384 + (4 * t + 2) * 1024); R2[8 + 2 * t + 1] = FRAG(16384 + (4 * t + 3) * 1024); }
            SB();
            bf16x8 Sb[4];
#pragma unroll
            for (int s = 0; s < 4; ++s) Sb[s] = pack4(S[2 * s], S[2 * s + 1]);
            f32x4 P[4], O[4];
#pragma unroll
            for (int t = 0; t < 4; ++t) { P[t] = (f32x4){0.f, 0.f, 0.f, 0.f}; O[t] = (f32x4){0.f, 0.f, 0.f, 0.f}; }
            SB();
#pragma unroll
            for (int s = 0; s < 2; ++s) {
#pragma unroll
                for (int t = 0; t < 4; ++t) P[t] = MFMA16(R1[2 * t + s], Sb[s], P[t]);
#pragma unroll
                for (int t = 0; t < 4; ++t) O[t] = MFMA16(Sb[s], R1[8 + 2 * t + s], O[t]);
                SB();
            }
#pragma unroll
            for (int d = 0; d < 8; ++d) R1[d] = FRAG(32768 + (2 * d) * 1024);
#pragma unroll
            for (int t = 0; t < 4; ++t) R1[8 + t] = FRAG(49152 + (t * 2) * 1024);
            R1[12] = FRAG(49152 + 5 * 1024); R1[13] = FRAG(49152 + 7 * 1024);
            const LAS u32x4* up = (const LAS u32x4*)(L + 57344 + wave * 2048 + lane * 32);
            const u32x4 u0 = up[0], u1 = up[1];
            SB();
#pragma unroll
            for (int s = 0; s < 2; ++s) {
#pragma unroll
                for (int t = 0; t < 4; ++t) P[t] = MFMA16(R2[2 * t + s], Sb[2 + s], P[t]);
#pragma unroll
                for (int t = 0; t < 4; ++t) O[t] = MFMA16(Sb[2 + s], R2[8 + 2 * t + s], O[t]);
                SB();
            }
#pragma unroll
            for (int d = 0; d < 8; ++d) R2[d] = FRAG(32768 + (2 * d + 1) * 1024);
            SB();
            P[0] = (f32x4){bflo(u0.x), bfhi(u0.x), bflo(u0.y), bfhi(u0.y)} - P[0]; P[1] = (f32x4){bflo(u0.z), bfhi(u0.z), bflo(u0.w), bfhi(u0.w)} - P[1];
            P[2] = (f32x4){bflo(u1.x), bfhi(u1.x), bflo(u1.y), bfhi(u1.y)} - P[2]; P[3] = (f32x4){bflo(u1.z), bfhi(u1.z), bflo(u1.w), bfhi(u1.w)} - P[3];
            bf16x8 Vb[2]; Vb[0] = pack4(P[0], P[1]); Vb[1] = pack4(P[2], P[3]);
#pragma unroll
            for (int d = 0; d < 8; ++d) S[d] = S[d] * gl;
            SB();
#pragma unroll
            for (int d = 0; d < 8; ++d) S[d] = MFMA16(R1[d], Vb[0], S[d]);
#pragma unroll
            for (int t = 0; t < 4; ++t) O[t] = MFMA16(Vb[0], R1[8 + t], O[t]);
            SB();
#pragma unroll
            for (int d = 0; d < 8; ++d) S[d] = MFMA16(R2[d], Vb[1], S[d]);
            O[2] = MFMA16(Vb[1], R1[12], O[2]); O[3] = MFMA16(Vb[1], R1[13], O[3]);
            SB();
            bf16* orow = MIX + ((size_t)b * TSEQ + n * 64 + nn) * 1024 + h * 128 + (half * 2 + wave) * 16 + 4 * qq;
#pragma unroll
            for (int t = 0; t < 4; ++t) { u32x2 o; o.x = pk_bf16(O[t][0], O[t][1]); o.y = pk_bf16(O[t][2], O[t][3]); *(__attribute__((address_space(1))) u32x2*)(orow + (size_t)t * 16 * 1024) = o; }
#undef SB
        }
        if (wave < 2) asm volatile("s_waitcnt vmcnt(4) lgkmcnt(0)" ::: "memory");
        else if (pf) asm volatile("s_waitcnt vmcnt(2) lgkmcnt(0)" ::: "memory");
        else asm volatile("s_waitcnt vmcnt(0) lgkmcnt(0)" ::: "memory");
        __builtin_amdgcn_s_barrier(); asm volatile("" ::: "memory");
    }
    asm volatile("s_waitcnt vmcnt(0) lgkmcnt(0)" ::: "memory"); __syncthreads();
}
#undef FRAG

__device__ __forceinline__ void sc_chunk(int chunk, const bf16* PS, const float* scw, const float* scg, bf16* MIX, int tid) {
    const int wave = tid >> 6, lane = tid & 63, tq = lane >> 4, jj = lane & 15;
#pragma unroll 1
    for (int it = 0; it < 8; ++it) {
        const int wi = wave * 8 + it, quad = wi >> 2, grp = wi & 3;
        const int token = chunk * 64 + quad * 4 + tq, tin = token & (TSEQ - 1), ch = grp * 128 + 8 * jj;
        const bf16* base = PS + (size_t)token * 1536 + ch;
        const u32x4 Bv = *(const u32x4*)base;
        float cv[8];
#pragma unroll
        for (int e = 0; e < 8; ++e) cv[e] = 0.f;
#pragma unroll
        for (int d = 0; d < 3; ++d) {
            if (tin - d >= 0) {
                const u32x4 Cv = *(const u32x4*)(base - (size_t)d * 1536 + 512), Hv = *(const u32x4*)(base - (size_t)d * 1536 + 1024);
                const float* wp = scw + (2 - d) * 512 + ch; const f32x4 w0 = *(const f32x4*)wp, w1 = *(const f32x4*)(wp + 4);
                cv[0] += w0.x * (bflo(Cv.x) * bflo(Hv.x)); cv[1] += w0.y * (bfhi(Cv.x) * bfhi(Hv.x)); cv[2] += w0.z * (bflo(Cv.y) * bflo(Hv.y)); cv[3] += w0.w * (bfhi(Cv.y) * bfhi(Hv.y));
                cv[4] += w1.x * (bflo(Cv.z) * bflo(Hv.z)); cv[5] += w1.y * (bfhi(Cv.z) * bfhi(Hv.z)); cv[6] += w1.z * (bflo(Cv.w) * bflo(Hv.w)); cv[7] += w1.w * (bfhi(Cv.w) * bfhi(Hv.w));
            }
        }
        float y[8] = {bflo(Bv.x) * cv[0], bfhi(Bv.x) * cv[1], bflo(Bv.y) * cv[2], bfhi(Bv.y) * cv[3], bflo(Bv.z) * cv[4], bfhi(Bv.z) * cv[5], bflo(Bv.w) * cv[6], bfhi(Bv.w) * cv[7]};
        float ssq = 0.f;
#pragma unroll
        for (int e = 0; e < 8; ++e) ssq += y[e] * y[e];
        ssq = sum16(ssq);
        const float rn = rsqrtf(ssq * (1.0f / 128.0f) + 1e-6f);
        const f32x4 g0 = *(const f32x4*)(scg + ch), g1 = *(const f32x4*)(scg + ch + 4);
        u32x4 o; o.x = pk_bf16(y[0] * rn * g0.x, y[1] * rn * g0.y); o.y = pk_bf16(y[2] * rn * g0.z, y[3] * rn * g0.w); o.z = pk_bf16(y[4] * rn * g1.x, y[5] * rn * g1.y); o.w = pk_bf16(y[6] * rn * g1.z, y[7] * rn * g1.w);
        *(u32x4*)(MIX + (size_t)token * 1024 + 512 + ch) = o;
    }
}

#define XB_TMO      128
#define XB_XCNT(j)  (256  + 64 * (j))
#define XB_XSUB(j)  (1280 + 64 * (j))
#define XB_XGEN(j)  (2304 + 64 * (j))
#define XB_TOP      3328
#define XB_TOPGEN   3392
#define XCD_BAR_WORDS 3456
#define XB_SPIN_CAP (1u << 18)

__device__ __forceinline__ unsigned xb_ld(unsigned* p)              { return __hip_atomic_load(p, __ATOMIC_RELAXED, __HIP_MEMORY_SCOPE_AGENT); }
__device__ __forceinline__ unsigned xb_add(unsigned* p, unsigned v) { return __hip_atomic_fetch_add(p, v, __ATOMIC_RELAXED, __HIP_MEMORY_SCOPE_AGENT); }
__device__ __forceinline__ unsigned xb_xcc_id() { return (unsigned)__builtin_amdgcn_s_getreg((3 << 11) | 20) & 0xFu; }
#define XB_SPIN(cond, bar) do { unsigned _sp = 0; while (cond) { __builtin_amdgcn_s_sleep(1); \
    if ((++_sp & 255u) == 0u) { if (xb_ld(&(bar)[XB_TMO])) break; if (_sp > XB_SPIN_CAP) { atomicAdd(&(bar)[XB_TMO], 1u); break; } } } } while (0)

struct XcdBarrier {
    unsigned* bar; unsigned x;
    volatile LAS unsigned* st;
};

__device__ __forceinline__ XcdBarrier xcd_barrier_post(unsigned* bar, volatile LAS unsigned* st) {
    XcdBarrier b; b.bar = bar; b.x = xb_xcc_id(); b.st = st;
    if (threadIdx.x == 0) (void)xb_add(&bar[XB_XCNT(b.x)], 1u);
    return b;
}
__device__ __forceinline__ void xcd_barrier_complete(unsigned* bar, unsigned x, unsigned& nloc, unsigned& nx) {
    const unsigned G = gridDim.x * gridDim.y * gridDim.z;
    unsigned sum, cnt, mine, sp = 0u;
    for (;;) {
        sum = 0u; cnt = 0u; mine = 0u;
#pragma unroll
        for (unsigned j = 0; j < 16; ++j) { const unsigned c = xb_ld(&bar[XB_XCNT(j)]); sum += c; cnt += (c > 0u) ? 1u : 0u; mine = (j == x) ? c : mine; }
        if (sum == G) break;
        __builtin_amdgcn_s_sleep(1);
        if ((++sp & 255u) == 0u) { if (xb_ld(&bar[XB_TMO])) break; if (sp > XB_SPIN_CAP) { atomicAdd(&bar[XB_TMO], 1u); break; } }
    }
    nloc = mine > 0u ? mine : 1u; nx = cnt > 0u ? cnt : 1u;
}

__device__ __forceinline__ void xcd_barrier(const XcdBarrier& b) {
    asm volatile("s_waitcnt vmcnt(0)" ::: "memory");
    __syncthreads();
    if (threadIdx.x == 0) {
        unsigned* bar = b.bar;
        __builtin_amdgcn_s_waitcnt(0);
        unsigned nloc = b.st[0], nx = b.st[1];
        if (nloc == 0u) { xcd_barrier_complete(bar, b.x, nloc, nx); b.st[0] = nloc; b.st[1] = nx; }
        const unsigned old = xb_add(&bar[XB_XSUB(b.x)], 1u);
        const unsigned gen = old / nloc;
        if (old + 1u == (gen + 1u) * nloc) {
            __builtin_amdgcn_fence(__ATOMIC_RELEASE, "agent");
            asm volatile("s_waitcnt vmcnt(0)" ::: "memory");
            const unsigned og = xb_add(&bar[XB_TOP], 1u);
            const unsigned tg = og / nx;
            if (og + 1u == (tg + 1u) * nx) xb_add(&bar[XB_TOPGEN], 1u);
            else XB_SPIN(xb_ld(&bar[XB_TOPGEN]) == tg, bar);
            __builtin_amdgcn_fence(__ATOMIC_ACQUIRE, "agent");
            xb_add(&bar[XB_XGEN(b.x)], 1u);
            asm volatile("s_waitcnt vmcnt(0)" ::: "memory");
        } else {
            XB_SPIN(xb_ld(&bar[XB_XGEN(b.x)]) == gen, bar);
            __builtin_amdgcn_fence(__ATOMIC_ACQUIRE, "agent");
            asm volatile("s_waitcnt vmcnt(0)" ::: "memory");
        }
    }
    __syncthreads();
}

#define GRID_BAR() do { XcdBarrier _b; _b.bar = (unsigned*)(launder_p(a.ws) + WS_CTL + 4096); _b.x = xb_xcc_id(); _b.st = (volatile LAS unsigned*)(lds + 131072 + 1024); xcd_barrier(_b); } while (0)
__global__ void __launch_bounds__(512, 2) hybrid_fwd(Args a) {
    extern __shared__ __attribute__((aligned(16))) unsigned char lds_raw[];
    LAS unsigned char* lds = (LAS unsigned char*)lds_raw;
    cg::grid_group grid = cg::this_grid();
    const int tid0 = threadIdx.x;
    if (tid0 < 8) ((LAS unsigned*)(lds + 131072 + 1024))[tid0] = 0u;
    __syncthreads();
    grid.sync();
    (void)xcd_barrier_post((unsigned*)(launder_p(a.ws) + WS_CTL + 4096), (volatile LAS unsigned*)(lds + 131072 + 1024));
    const int wave_s = __builtin_amdgcn_readfirstlane(threadIdx.x >> 6), bx = blockIdx.x, G = gridDim.x;
#define tid fresh_tid(wave_s)
    p0_prologue(a, lds, G, bx, tid);
    GRID_BAR();

#pragma unroll 1
    for (int l = 0; l < NLAYER; ++l) {
#define WSP(off) (launder_p(a.ws) + (off))
        {
            unsigned char* w = launder_p(a.ws);
            pg8::Gemm g{(const bf16*)(w + WS_XB), (const bf16*)(w + WS_W + (size_t)l * LW + LW_IN), MTOK, NIN, DM}; pg8::StaticOrder S; S.init(MTOK, NIN, G, bx);
            pg8::EpiInProj E{(bf16*)(w + WS_PA), (bf16*)(w + WS_PZ), (bf16*)(w + WS_PS), (float*)(w + WS_BG), (const float*)(w + WS_SSP1), INP(4) + l * 4, INP(5) + l * 4};
            for (int rep = 0; rep < PROBE_G1; ++rep)
            pg8::gemm_phase<pg8::EpiInProj, pg8::StaticOrder, true, true>(lds, g, S, E, tid);
        }
        GRID_BAR();
        {
            unsigned char* w = launder_p(a.ws);
            const float* cwp = INP(3) + (size_t)l * 4 * 1536;
            {
                const int t3 = launder_v(tid);
                for (int i = t3; i < 4 * 4 * 384; i += 512) { const int hh = i / 1536, r2 = i % 1536, tap = r2 / 384, c2 = r2 % 384, s2 = c2 >> 7, ch = c2 & 127;
                    ((LAS float*)(lds + M1_CW))[i] = cwp[tap * 1536 + s2 * 512 + hh * 128 + ch]; }
                __syncthreads();
            }
            for (int rep = 0; rep < PROBE_M1; ++rep)
            for (int u = bx; u < 4096; u += G) m1_unit(lds, u, (const bf16*)(w + WS_PA), (const float*)(w + WS_BG), cwp, w + WS_INTER, (float*)(w + WS_SS), tid);
        }
        GRID_BAR();
        for (int rep = 0; rep < PROBE_SCAN; ++rep)
        for (int su = bx; su < 128; su += G) { unsigned char* w = launder_p(a.ws); const int xcd = su & 7, kk = su >> 3; scan_unit(lds, xcd * 4 + (kk >> 2), kk & 3, w + WS_INTER, (const float*)(w + WS_SS), (bf16*)(w + WS_MIX), launder_v(tid)); }
        {
            LAS unsigned* sh = (LAS unsigned*)(lds + 131072);
            unsigned char* w = launder_p(a.ws); unsigned* ctl = (unsigned*)(w + WS_CTL); const bf16* PS = (const bf16*)(w + WS_PS); bf16* MIX = (bf16*)(w + WS_MIX);
            const float* scw = INP(7) + (size_t)l * 3 * 512; const float* scg = INP(8) + (size_t)l * 512;
            for (;;) {
                if (tid == 0) sh[0] = atomicAdd(ctl + 64 * l, 1u);
                LDS_BAR();
                const unsigned c = sh[0];
                LDS_BAR();
                if (c >= 1024u) break;
                sc_chunk((int)c, PS, scw, scg, MIX, launder_v(tid));
            }
        }
        GRID_BAR();
        {
            unsigned char* w = launder_p(a.ws); bf16* MIX = (bf16*)(w + WS_MIX); const bf16* PZ = (const bf16*)(w + WS_PZ);
            const int tid5 = launder_v(tid), G5 = launder_i(G); const float* gn = INP(6) + l * 128; const int jj = tid5 & 15; const f32x4 g0 = *(const f32x4*)(gn + 8 * jj), g1 = *(const f32x4*)(gn + 8 * jj + 4);
            const int istride = (G5 * 512) >> 4;
#pragma unroll 1
            for (int item0 = (bx * 512 + tid5) >> 4; item0 < MTOK * 4; item0 += 4 * istride) {
                u32x4 ov[4], zv[4];
#pragma unroll
                for (int q = 0; q < 4; ++q) { const int item = item0 + q * istride, it2 = item < MTOK * 4 ? item : item0, token = it2 >> 2, hd = it2 & 3;
                    ov[q] = *(const u32x4*)(MIX + (size_t)token * 1024 + hd * 128 + 8 * jj); zv[q] = *(const u32x4*)(PZ + (size_t)token * 512 + hd * 128 + 8 * jj); }
#pragma unroll
                for (int q = 0; q < 4; ++q) { const int item = item0 + q * istride; if (item < MTOK * 4) { const int token = item >> 2, hd = item & 3;
                    float o[8] = {bflo(ov[q].x), bfhi(ov[q].x), bflo(ov[q].y), bfhi(ov[q].y), bflo(ov[q].z), bfhi(ov[q].z), bflo(ov[q].w), bfhi(ov[q].w)};
                    float z[8] = {bflo(zv[q].x), bfhi(zv[q].x), bflo(zv[q].y), bfhi(zv[q].y), bflo(zv[q].z), bfhi(zv[q].z), bflo(zv[q].w), bfhi(zv[q].w)};
                    float ssq = 0.f;
#pragma unroll
                    for (int e = 0; e < 8; ++e) ssq += o[e] * o[e];
                    ssq = sum16(ssq);
                    const float rn = rsqrtf(ssq * (1.0f / 128.0f) + 1e-6f);
                    const float gg[8] = {g0.x, g0.y, g0.z, g0.w, g1.x, g1.y, g1.z, g1.w};
#pragma unroll
                    for (int e = 0; e < 8; ++e) o[e] = o[e] * rn * gg[e] * (z[e] * __builtin_amdgcn_rcpf(1.0f + __expf(-z[e])));
                    u32x4 w; w.x = pk_bf16(o[0], o[1]); w.y = pk_bf16(o[2], o[3]); w.z = pk_bf16(o[4], o[5]); w.w = pk_bf16(o[6], o[7]);
                    *(u32x4*)(MIX + (size_t)token * 1024 + hd * 128 + 8 * jj) = w; } }
            }
        }
        GRID_BAR();
        {
            unsigned char* w = launder_p(a.ws);
            pg8::Gemm g{(const bf16*)(w + WS_MIX), (const bf16*)(w + WS_W + (size_t)l * LW + LW_OUT), MTOK, DM, DM}; pg8::StaticOrder S; S.init(MTOK, DM, G, bx);
            pg8::EpiResid E{(bf16*)(w + WS_XB), (float*)(w + WS_SSP2)};
            pg8::gemm_phase<pg8::EpiResid, pg8::StaticOrder, true, true>(lds, g, S, E, tid);
        }
        GRID_BAR();
        {
            unsigned char* w = launder_p(a.ws);
            pg8::Gemm g{(const bf16*)(w + WS_XB), (const bf16*)(w + WS_W + (size_t)l * LW + LW_GU), MTOK, NGU, DM}; pg8::StaticOrder S; S.init(MTOK, NGU, G, bx);
            pg8::EpiSwiGLU E{(bf16*)(w + WS_ACT), (const float*)(w + WS_SSP2)};
            for (int rep = 0; rep < PROBE_G3; ++rep)
            pg8::gemm_phase<pg8::EpiSwiGLU, pg8::StaticOrder, true, true>(lds, g, S, E, tid);
        }
        GRID_BAR();
        {
            unsigned char* w = launder_p(a.ws);
            pg8::Gemm g{(const bf16*)(w + WS_ACT), (const bf16*)(w + WS_W + (size_t)l * LW + LW_DN), MTOK, DM, FF}; pg8::StaticOrder S; S.init(MTOK, DM, G, bx);
            pg8::EpiResid E{(bf16*)(w + WS_XB), (float*)(w + WS_SSP1)};
            pg8::gemm_phase<pg8::EpiResid, pg8::StaticOrder, true, true>(lds, g, S, E, tid);
        }
        GRID_BAR();
    }
    {
        unsigned char* w = launder_p(a.ws); float* X = (float*)launder_p((unsigned char*)a.out); const float* SS1 = (const float*)(w + WS_SSP1);
        const int tidf = launder_v(tid), lane = tidf & 63;
        const float* gf = INP(14); const int gw = bx * 8 + (tidf >> 6), NGW = G * 8;
        f32x4 gv[4];
#pragma unroll
        for (int j = 0; j < 4; ++j) gv[j] = ((const f32x4*)gf)[lane + 64 * j];
        const bf16* XBf = (const bf16*)(w + WS_XB);
        for (int m = gw; m < MTOK; m += 2 * NGW) {
            const int m2 = m + NGW < MTOK ? m + NGW : m;
            const u32x2* xbr = (const u32x2*)(XBf + (size_t)m * DM) + lane; const u32x2* xbr2 = (const u32x2*)(XBf + (size_t)m2 * DM) + lane;
            u32x2 p[4], p2[4];
#pragma unroll
            for (int j = 0; j < 4; ++j) { p[j] = xbr[64 * j]; p2[j] = xbr2[64 * j]; }
            const float rn = pg8::row_rs(SS1, m), rn2 = pg8::row_rs(SS1, m2);
            f32x4* xr = (f32x4*)(X + (size_t)m * DM) + lane; f32x4* xr2 = (f32x4*)(X + (size_t)m2 * DM) + lane;
#pragma unroll
            for (int j = 0; j < 4; ++j) { f32x4 v = {bflo(p[j].x), bfhi(p[j].x), bflo(p[j].y), bfhi(p[j].y)}; v = v * rn * gv[j]; xr[64 * j] = v; }
            if (m2 != m) {
#pragma unroll
                for (int j = 0; j < 4; ++j) { f32x4 v = {bflo(p2[j].x), bfhi(p2[j].x), bflo(p2[j].y), bfhi(p2[j].y)}; v = v * rn2 * gv[j]; xr2[64 * j] = v; }
            }
        }
    }
}

extern "C" void kernel_launch(void* const* d_in, const int* in_sizes, int n_in, void* d_out, int out_size, void* d_ws, size_t ws_size, hipStream_t stream) {
    static int grid_blocks = 0;
    if (grid_blocks == 0) {
        if (n_in != 15 || in_sizes[0] != MTOK * DM || out_size != MTOK * DM || ws_size < WS_END) { fprintf(stderr, "kernel_launch: unexpected shapes (n_in %d, in0 %d, out %d, ws %zu)\n", n_in, n_in > 0 ? in_sizes[0] : -1, out_size, ws_size); grid_blocks = -1; return; }
        int dev = 0, cus = 0, per_cu = 0;
        hipGetDevice(&dev); hipDeviceGetAttribute(&cus, hipDeviceAttributeMultiprocessorCount, dev);
        if (hipFuncSetAttribute((const void*)hybrid_fwd, hipFuncAttributeMaxDynamicSharedMemorySize, LDS_BYTES) != hipSuccess) { fprintf(stderr, "kernel_launch: hipFuncSetAttribute failed\n"); grid_blocks = -1; return; }
        if (hipOccupancyMaxActiveBlocksPerMultiprocessor(&per_cu, (const void*)hybrid_fwd, 512, LDS_BYTES) != hipSuccess || per_cu < 1) { fprintf(stderr, "kernel_launch: occupancy query gave %d\n", per_cu); per_cu = 1; }
        (void)hipGetLastError();
        grid_blocks = cus * 1;
        fprintf(stderr, "kernel_launch: cus %d per_cu %d grid %d\n", cus, per_cu, grid_blocks);
    }
    if (grid_blocks < 0) return;
    hipMemsetAsync((char*)d_ws + WS_CTL, 0, 4096 + 16384, stream);
    Args a{};
    for (int i = 0; i < 15; ++i) a.in[i] = (const float*)d_in[i];
    a.out = (float*)d_out; a.ws = (unsigned char*)d_ws;
    void* args[] = {&a};
    hipError_t e = hipLaunchCooperativeKernel((const void*)hybrid_fwd, dim3(grid_blocks), dim3(512), args, LDS_BYTES, stream);
    if (e != hipSuccess) fprintf(stderr, "cooperative launch failed: %s (grid %d)\n", hipGetErrorString(e), grid_blocks);
}
```

```cpp
#include <hip/hip_runtime.h>
#include <hip/hip_cooperative_groups.h>
#include <cstdio>
#include <cstdint>
namespace cg = cooperative_groups;
namespace pg8 {
#define PG8_LAS __attribute__((address_space(3)))
typedef unsigned short bf16_t;
typedef short bf16x8 __attribute__((ext_vector_type(8)));
typedef float f32x4 __attribute__((ext_vector_type(4)));
typedef unsigned u32x4 __attribute__((ext_vector_type(4)));
constexpr int BM = 256, BK = 64, HALF = 128, HTB = HALF * BK * 2  , STAGE_BYTES = 8 * HTB, NXCD = 8, WGM = 8;

__host__ __device__ __forceinline__ int lds_byte(int r, int c) { const int st = (r >> 4) * 2 + (c >> 5), rr = r & 15, cc = c & 31, ob = rr * 64 + cc * 2; return st * 1024 + (ob ^ (((ob >> 9) & 1) << 5)); }
__host__ __device__ __forceinline__ void stage_rc(int b, int& R, int& C) { const int st = b / 1024, sb = b % 1024, swz = sb ^ (((sb >> 9) & 1) << 5); R = (st >> 1) * 16 + swz / 64; C = (st & 1) * 32 + (swz % 64) / 2; }
__host__ __device__ __forceinline__ int perm32(int rho) { const int n = rho >> 4, i = rho & 15; return 8 * (i >> 2) + 4 * n + (i & 3); }

struct Unit { int pm, pn; };
struct Gemm { const bf16_t* A; const bf16_t* Bt; int M, N, K; };

struct StaticOrder {
    int nM, nN, nwg, G, c;
    __host__ __device__ void init(int M, int N, int G_, int c_) { nM = M / BM; nN = N / BM; nwg = nM * nN; G = G_; c = c_; }
    __host__ __device__ bool next(int i, Unit& u) const {
        const long L = (long)i * G + c; if (L >= nwg) return false;
        int wgid = (int)L; { const int q = nwg / NXCD, r = nwg % NXCD, xcd = wgid % NXCD, off = wgid / NXCD; wgid = (xcd < r ? xcd * (q + 1) : r * (q + 1) + (xcd - r) * q) + off; }
        const int nig = WGM * nN, gid = wgid / nig, fm = gid * WGM, gsz = (nM - fm) < WGM ? (nM - fm) : WGM;
        u.pm = fm + ((wgid % nig) % gsz); u.pn = (wgid % nig) / gsz; return true;
    }
    __device__ __forceinline__ void a_ready(const Unit&) const {}
    __device__ __forceinline__ void done(const Unit&) const {}
};

typedef float f32x2 __attribute__((ext_vector_type(2)));
typedef __bf16 bf16x2_t __attribute__((ext_vector_type(2)));
__device__ __forceinline__ unsigned pk_bf16(float lo, float hi) { f32x2 v = {lo, hi}; bf16x2_t b = __builtin_convertvector(v, bf16x2_t); return __builtin_bit_cast(unsigned, b); }
__device__ __forceinline__ float sigmoid_f(float x) { return __builtin_amdgcn_rcpf(1.0f + __expf(-x)); }
__device__ __forceinline__ float row_rs(const float* ssp, int row) {
    const f32x4* p = (const f32x4*)(ssp + (size_t)row * 16); const f32x4 a = p[0], b = p[1], c = p[2], d = p[3];
    const float s = (((a.x + a.y) + (a.z + a.w)) + ((b.x + b.y) + (b.z + b.w))) + (((c.x + c.y) + (c.z + c.w)) + ((d.x + d.y) + (d.z + d.w)));
    return rsqrtf(s * (1.0f / 1024.0f) + 1e-6f);
}

__device__ __forceinline__ void row_rs8(const float* ssp, int row0, int fq, float (&rr)[8]) {
    f32x4 pv[8];
#pragma unroll
    for (int k = 0; k < 8; ++k) pv[k] = *(const __attribute__((address_space(1))) f32x4*)(ssp + (size_t)(row0 + (k >> 2) * HALF + (k & 3) * 16) * 16 + 4 * fq);
#pragma unroll
    for (int k = 0; k < 8; ++k) { float s = (pv[k].x + pv[k].y) + (pv[k].z + pv[k].w); s += __shfl_xor(s, 16); s += __shfl_xor(s, 32); rr[k] = rsqrtf(s * (1.0f / 1024.0f) + 1e-6f); }
}

struct EpiInProj {
    static constexpr bool PERM = true, AFTER_DRAIN = false;
    bf16_t* PA; bf16_t* PZ; bf16_t* PS; float* BG; const float* ss; const float* a_log; const float* dt_bias;
    __device__ __forceinline__ void operator()(const f32x4 (&acc)[2][2][4][2], const Unit& u, int wr, int wc, int fr, int fq) const {
        const int row0 = u.pm * BM + wr * 64 + fr;
        float rr[8]; row_rs8(ss, row0, fq, rr);
        if (u.pn < 14) {
            bf16_t* base; int ldc, colt;
            if (u.pn < 6) { base = PA; ldc = 1536; colt = u.pn * 256; }
            else if (u.pn < 8) { base = PZ; ldc = 512; colt = (u.pn - 6) * 256; }
            else { base = PS; ldc = 1536; colt = (u.pn - 8) * 256; }
            const int col0 = colt + wc * 32 + 8 * fq;
#pragma unroll
            for (int ai = 0; ai < 2; ++ai)
#pragma unroll
                for (int m = 0; m < 4; ++m) {
                    const int row = row0 + ai * HALF + m * 16;
                    const float r = rr[ai * 4 + m];
                    bf16_t* rowp = base + (size_t)row * ldc + col0;
#pragma unroll
                    for (int bj = 0; bj < 2; ++bj) {
                        const f32x4 v0 = acc[ai][bj][m][0] * r, v1 = acc[ai][bj][m][1] * r;
                        u32x4 w; w.x = pk_bf16(v0[0], v0[1]); w.y = pk_bf16(v0[2], v0[3]); w.z = pk_bf16(v1[0], v1[1]); w.w = pk_bf16(v1[2], v1[3]);
                        *(__attribute__((address_space(1))) u32x4*)(rowp + bj * HALF) = w;
                    }
                }
        } else if (wc == 0) {
            if (fq == 0) {
                const f32x4 al = *(const f32x4*)a_log, db = *(const f32x4*)dt_bias;
                const f32x4 ea = {__expf(al[0]), __expf(al[1]), __expf(al[2]), __expf(al[3])};
#pragma unroll
                for (int ai = 0; ai < 2; ++ai)
#pragma unroll
                    for (int m = 0; m < 4; ++m) {
                        const int row = row0 + ai * HALF + m * 16;
                        const float r = rr[ai * 4 + m];
                        const f32x4 bi = acc[ai][0][m][0] * r, av = acc[ai][0][m][1] * r;
                        f32x4 be, gg;
#pragma unroll
                        for (int h = 0; h < 4; ++h) {
                            be[h] = __builtin_amdgcn_rcpf(1.0f + __expf(-bi[h]));
                            const float xx = av[h] + db[h], ee = __expf(xx);
                            const float sp = xx > 20.f ? xx : (ee < 0.03f ? ee * (1.0f - ee * (0.5f - ee * (0.33333334f - 0.25f * ee))) : __logf(1.0f + ee));
                            gg[h] = -ea[h] * sp;
                        }
                        *(__attribute__((address_space(1))) f32x4*)(BG + (size_t)row * 8) = be; *(__attribute__((address_space(1))) f32x4*)(BG + (size_t)row * 8 + 4) = gg;
                    }
            }
        }
    }
};

struct EpiResid {
    static constexpr bool PERM = true, AFTER_DRAIN = false;
    bf16_t* xb; float* ss;
    __device__ __forceinline__ void operator()(const f32x4 (&acc)[2][2][4][2], const Unit& u, int wr, int wc, int fr, int fq) const {
        const int row0 = u.pm * BM + wr * 64 + fr, col0 = u.pn * BM + wc * 32 + 8 * fq;
        u32x4 xin[8][2];
#pragma unroll
        for (int k = 0; k < 8; ++k)
#pragma unroll
            for (int bj = 0; bj < 2; ++bj) xin[k][bj] = *(const __attribute__((address_space(1))) u32x4*)(xb + (size_t)(row0 + (k >> 2) * HALF + (k & 3) * 16) * 1024 + col0 + bj * HALF);
#pragma unroll
        for (int ai = 0; ai < 2; ++ai)
#pragma unroll
            for (int m = 0; m < 4; ++m) {
                const int row = row0 + ai * HALF + m * 16; const size_t off = (size_t)row * 1024 + col0;
                float sq = 0.f;
#pragma unroll
                for (int bj = 0; bj < 2; ++bj) {
                    const u32x4 xv = xin[ai * 4 + m][bj];
                    const f32x4 a0 = acc[ai][bj][m][0], a1 = acc[ai][bj][m][1];
                    u32x4 w;
                    w.x = pk_bf16(__uint_as_float(xv.x << 16) + a0[0], __uint_as_float(xv.x & 0xffff0000u) + a0[1]);
                    w.y = pk_bf16(__uint_as_float(xv.y << 16) + a0[2], __uint_as_float(xv.y & 0xffff0000u) + a0[3]);
                    w.z = pk_bf16(__uint_as_float(xv.z << 16) + a1[0], __uint_as_float(xv.z & 0xffff0000u) + a1[1]);
                    w.w = pk_bf16(__uint_as_float(xv.w << 16) + a1[2], __uint_as_float(xv.w & 0xffff0000u) + a1[3]);
                    *(__attribute__((address_space(1))) u32x4*)(xb + off + bj * HALF) = w;
                    const float r0 = __uint_as_float(w.x << 16), r1 = __uint_as_float(w.x & 0xffff0000u), r2 = __uint_as_float(w.y << 16), r3 = __uint_as_float(w.y & 0xffff0000u);
                    const float r4 = __uint_as_float(w.z << 16), r5 = __uint_as_float(w.z & 0xffff0000u), r6 = __uint_as_float(w.w << 16), r7 = __uint_as_float(w.w & 0xffff0000u);
                    sq += ((r0 * r0 + r1 * r1) + (r2 * r2 + r3 * r3)) + ((r4 * r4 + r5 * r5) + (r6 * r6 + r7 * r7));
                }
                sq += __shfl_xor(sq, 16); sq += __shfl_xor(sq, 32);
                if (fq == 0) *(__attribute__((address_space(1))) float*)(ss + (size_t)row * 16 + u.pn * 4 + wc) = sq;
                asm volatile("" ::: "memory");
            }
    }
};

struct EpiSwiGLU {
    static constexpr bool PERM = true, AFTER_DRAIN = false;
    bf16_t* act; const float* ss;
    __device__ __forceinline__ void operator()(const f32x4 (&acc)[2][2][4][2], const Unit& u, int wr, int wc, int fr, int fq) const {
        const int row0 = u.pm * BM + wr * 64 + fr, col0 = u.pn * HALF + wc * 32 + 8 * fq;
        float rr[8]; row_rs8(ss, row0, fq, rr);
#pragma unroll
        for (int ai = 0; ai < 2; ++ai)
#pragma unroll
            for (int m = 0; m < 4; ++m) {
                const int row = row0 + ai * HALF + m * 16;
                const float r = rr[ai * 4 + m];
                float o[8];
#pragma unroll
                for (int n = 0; n < 2; ++n)
#pragma unroll
                    for (int j = 0; j < 4; ++j) { const float g = acc[ai][0][m][n][j] * r, up = acc[ai][1][m][n][j] * r; o[n * 4 + j] = g * sigmoid_f(g) * up; }
                u32x4 w; w.x = pk_bf16(o[0], o[1]); w.y = pk_bf16(o[2], o[3]); w.z = pk_bf16(o[4], o[5]); w.w = pk_bf16(o[6], o[7]);
                *(__attribute__((address_space(1))) u32x4*)(act + (size_t)row * 2816 + col0) = w;
            }
    }
};

template <class Epi, class Sched, bool ALIGN_EPI = false, bool SP2 = false>
__device__ __forceinline__ void gemm_phase(PG8_LAS unsigned char* lds, const Gemm g, const Sched& S, const Epi& E, int tid_arg) {
    int tid_l = tid_arg; asm volatile("" : "+v"(tid_l));
    const int tid = tid_l, wid = __builtin_amdgcn_readfirstlane(tid >> 6), lane = tid & 63, wr = wid >> 2, wc = wid & 3, fr = lane & 15, fq = lane >> 4;
    const int K = g.K, nt = K / BK;
    unsigned voffA[2], voffB[2];
#pragma unroll
    for (int i = 0; i < 2; ++i) { int R, C; stage_rc(tid * 16 + i * 8192, R, C); const int Rb = Epi::PERM ? ((R & ~31) + perm32(R & 31)) : R;
        voffA[i] = (unsigned)(R * K + C) * 2u; voffB[i] = (unsigned)(Rb * K + C) * 2u; }
    const size_t kstep = (size_t)(BK * 2);
    const size_t hstep = (size_t)HALF * K * 2;
    const size_t tstep = 2 * hstep;
    const unsigned ldsw = (unsigned)wid * 1024u;
    const int aoff = lds_byte(wr * 64 + fr, fq * 8), boff = lds_byte(wc * 32 + fr, fq * 8);
#define PG8_SA(b, h) (((b) * 2 + (h)) * HTB)
#define PG8_SB(b, h) ((4 + (b) * 2 + (h)) * HTB)
#define PG8_STAGE(bufoff, gbase, voff) do { _Pragma("unroll") for (int _i = 0; _i < 2; ++_i) \
        __builtin_amdgcn_global_load_lds((const unsigned*)((const char*)(gbase) + (voff)[_i]), (PG8_LAS unsigned*)(lds + (bufoff) + ldsw + _i * 8192), 16, 0, 0); } while (0)
#define PG8_LDA(dst, b, h) do { _Pragma("unroll") for (int m = 0; m < 4; ++m) _Pragma("unroll") for (int k = 0; k < 2; ++k) dst[m][k] = *(const PG8_LAS bf16x8*)(lds + PG8_SA(b, h) + aoff + m * 2048 + k * 1024); } while (0)
#define PG8_LDB(dst, b, h) do { _Pragma("unroll") for (int n = 0; n < 2; ++n) _Pragma("unroll") for (int k = 0; k < 2; ++k) dst[n][k] = *(const PG8_LAS bf16x8*)(lds + PG8_SB(b, h) + boff + n * 2048 + k * 1024); } while (0)
#define PG8_MMA(ai, bj, At, Bt) do { __builtin_amdgcn_s_setprio(1); _Pragma("unroll") for (int m = 0; m < 4; ++m) _Pragma("unroll") for (int n = 0; n < 2; ++n) _Pragma("unroll") for (int k = 0; k < 2; ++k) \
        acc[ai][bj][m][n] = __builtin_amdgcn_mfma_f32_16x16x32_bf16(Bt[n][k], At[m][k], acc[ai][bj][m][n], 0, 0, 0); __builtin_amdgcn_s_setprio(0); } while (0)
#define PG8_WAIT_V(n) asm volatile("s_waitcnt vmcnt(" #n ")" ::: "memory")
#define PG8_WAIT_L(n) asm volatile("s_waitcnt lgkmcnt(" #n ")" ::: "memory")
#define PG8_BAR __builtin_amdgcn_s_barrier()
#define PG8_SCHED __builtin_amdgcn_sched_barrier(0)
    Unit cur, nxt; int ui = 0;
    if (!S.next(0, cur)) return;
    f32x4 acc[2][2][4][2];
#pragma unroll
    for (int a = 0; a < 2; ++a)
#pragma unroll
        for (int b = 0; b < 2; ++b)
#pragma unroll
            for (int m = 0; m < 4; ++m)
#pragma unroll
                for (int n = 0; n < 2; ++n) acc[a][b][m][n] = (f32x4){0.f, 0.f, 0.f, 0.f};
    bf16x8 At[4][2], B0[2][2], B1[2][2];
    const char* cA = (const char*)g.A + (size_t)cur.pm * tstep; const char* cB = (const char*)g.Bt + (size_t)cur.pn * tstep;
    S.a_ready(cur);
    if constexpr (SP2) {
        PG8_STAGE(PG8_SB(0, 0), cB, voffB); PG8_STAGE(PG8_SB(0, 1), cB + hstep, voffB); PG8_STAGE(PG8_SA(0, 0), cA, voffA); PG8_STAGE(PG8_SA(0, 1), cA + hstep, voffA);
        if (wr == 1) PG8_BAR;
        PG8_WAIT_V(2); PG8_BAR;
        PG8_STAGE(PG8_SB(1, 0), cB + kstep, voffB); PG8_STAGE(PG8_SA(1, 0), cA + kstep, voffA); PG8_STAGE(PG8_SB(1, 1), cB + hstep + kstep, voffB);
        PG8_WAIT_V(6); PG8_BAR;
    } else {
        PG8_STAGE(PG8_SB(0, 0), cB, voffB); PG8_STAGE(PG8_SA(0, 0), cA, voffA); PG8_STAGE(PG8_SB(0, 1), cB + hstep, voffB); PG8_STAGE(PG8_SA(0, 1), cA + hstep, voffA);
        if (wr == 1) PG8_BAR;
        PG8_WAIT_V(4); PG8_BAR;
        PG8_STAGE(PG8_SB(1, 0), cB + kstep, voffB); PG8_STAGE(PG8_SA(1, 0), cA + kstep, voffA); PG8_STAGE(PG8_SB(1, 1), cB + hstep + kstep, voffB);
        PG8_WAIT_V(6); PG8_BAR;
    }
    for (;;) {
        const bool has_next = S.next(ui + 1, nxt);
        const char* nA = has_next ? (const char*)g.A + (size_t)nxt.pm * tstep : cA; const char* nB = has_next ? (const char*)g.Bt + (size_t)nxt.pn * tstep : cB;
        for (int t = 0; t < nt; t += 2) {
            const bool last = (t == nt - 2);
            const char* a1 = cA + (size_t)(t + 1) * kstep;
            const char* a2 = last ? nA : cA + (size_t)(t + 2) * kstep; const char* b2 = last ? nB : cB + (size_t)(t + 2) * kstep;
            const char* a3 = a2 + kstep; const char* b3 = b2 + kstep;
            if (last && has_next) S.a_ready(nxt);
            if constexpr (SP2) {
            PG8_LDB(B0, 0, 0); PG8_LDB(B1, 0, 1); PG8_SCHED; PG8_LDA(At, 0, 0); PG8_STAGE(PG8_SA(1, 1), a1 + hstep, voffA);
            PG8_WAIT_V(8); PG8_WAIT_L(0); PG8_BAR; PG8_MMA(0, 0, At, B0); PG8_MMA(0, 1, At, B1); PG8_BAR; PG8_SCHED;
            PG8_LDA(At, 0, 1); PG8_STAGE(PG8_SB(0, 0), b2, voffB); PG8_STAGE(PG8_SB(0, 1), b2 + hstep, voffB); PG8_STAGE(PG8_SA(0, 0), a2, voffA);
            PG8_WAIT_V(8); PG8_WAIT_L(0); PG8_BAR; PG8_MMA(1, 0, At, B0); PG8_MMA(1, 1, At, B1); PG8_BAR; PG8_SCHED;
            PG8_LDB(B0, 1, 0); PG8_LDB(B1, 1, 1); PG8_SCHED; PG8_LDA(At, 1, 0); PG8_STAGE(PG8_SA(0, 1), a2 + hstep, voffA);
            PG8_WAIT_V(8); PG8_WAIT_L(0); PG8_BAR; PG8_MMA(0, 0, At, B0); PG8_MMA(0, 1, At, B1); PG8_BAR; PG8_SCHED;
            PG8_LDA(At, 1, 1); PG8_STAGE(PG8_SB(1, 0), b3, voffB); PG8_STAGE(PG8_SB(1, 1), b3 + hstep, voffB); PG8_STAGE(PG8_SA(1, 0), a3, voffA);
            PG8_WAIT_V(8); PG8_WAIT_L(0); PG8_BAR; PG8_MMA(1, 0, At, B0); PG8_MMA(1, 1, At, B1); PG8_BAR; PG8_SCHED;
            } else {
            PG8_LDB(B0, 0, 0); PG8_SCHED; PG8_LDA(At, 0, 0); PG8_STAGE(PG8_SA(1, 1), a1 + hstep, voffA);
            PG8_WAIT_L(8); PG8_BAR; PG8_WAIT_L(0); PG8_MMA(0, 0, At, B0); PG8_BAR; PG8_SCHED;
            PG8_LDB(B1, 0, 1); PG8_STAGE(PG8_SB(0, 0), b2, voffB);
            PG8_BAR; PG8_WAIT_L(0); PG8_MMA(0, 1, At, B1); PG8_BAR;
            PG8_LDA(At, 0, 1); PG8_STAGE(PG8_SA(0, 0), a2, voffA);
            PG8_BAR; PG8_WAIT_L(0); PG8_MMA(1, 0, At, B0); PG8_BAR; PG8_SCHED;
            PG8_STAGE(PG8_SB(0, 1), b2 + hstep, voffB);
            PG8_WAIT_V(6); PG8_BAR; PG8_MMA(1, 1, At, B1); PG8_BAR;
            PG8_LDB(B0, 1, 0); PG8_SCHED; PG8_LDA(At, 1, 0); PG8_STAGE(PG8_SA(0, 1), a2 + hstep, voffA);
            PG8_WAIT_L(8); PG8_BAR; PG8_WAIT_L(0); PG8_MMA(0, 0, At, B0); PG8_BAR; PG8_SCHED;
            PG8_LDB(B1, 1, 1); PG8_STAGE(PG8_SB(1, 0), b3, voffB);
            PG8_BAR; PG8_WAIT_L(0); PG8_MMA(0, 1, At, B1); PG8_BAR;
            PG8_LDA(At, 1, 1); PG8_STAGE(PG8_SA(1, 0), a3, voffA);
            PG8_BAR; PG8_WAIT_L(0); PG8_MMA(1, 0, At, B0); PG8_BAR; PG8_SCHED;
            PG8_STAGE(PG8_SB(1, 1), b3 + hstep, voffB);
            PG8_WAIT_V(6); PG8_BAR; PG8_MMA(1, 1, At, B1); PG8_BAR;
            }
        }
        if constexpr (ALIGN_EPI) { if (wr == 0) PG8_BAR; }
        if constexpr (!Epi::AFTER_DRAIN) { E(acc, cur, wr, wc, fr, fq); S.done(cur); }
        if (!has_next) break;
#pragma unroll
        for (int a = 0; a < 2; ++a)
#pragma unroll
            for (int b = 0; b < 2; ++b)
#pragma unroll
                for (int m = 0; m < 4; ++m)
#pragma unroll
                    for (int n = 0; n < 2; ++n) acc[a][b][m][n] = (f32x4){0.f, 0.f, 0.f, 0.f};
        cur = nxt; cA = nA; cB = nB; ++ui;
        if constexpr (ALIGN_EPI) { if (wr == 1) PG8_BAR; }
    }
    PG8_WAIT_V(0);
    if constexpr (!ALIGN_EPI) { if (wr == 0) PG8_BAR; }
    PG8_BAR;
    if constexpr (Epi::AFTER_DRAIN) { E.fused(acc, cur, wr, wc, fr, fq, lds, wid, lane); S.done(cur); }
#undef PG8_SA
#undef PG8_SB
#undef PG8_STAGE
#undef PG8_LDA
#undef PG8_LDB
#undef PG8_MMA
#undef PG8_WAIT_V
#undef PG8_WAIT_L
#undef PG8_BAR
#undef PG8_SCHED
}
}

#define LAS __attribute__((address_space(3)))
typedef unsigned short bf16;
typedef unsigned u32x4 __attribute__((ext_vector_type(4)));
typedef unsigned u32x2 __attribute__((ext_vector_type(2)));
typedef float f32x4 __attribute__((ext_vector_type(4)));
typedef float f32x16 __attribute__((ext_vector_type(16)));
typedef short bf16x8 __attribute__((ext_vector_type(8)));
using pg8::pk_bf16;
#define MFMA32(a, b, c) __builtin_amdgcn_mfma_f32_32x32x16_bf16((a), (b), (c), 0, 0, 0)

#ifndef PROBE_M1
#define PROBE_M1 1
#endif
#ifndef PROBE_SCAN
#define PROBE_SCAN 1
#endif
#ifndef PROBE_G1
#define PROBE_G1 1
#endif
#ifndef PROBE_G3
#define PROBE_G3 1
#endif
constexpr int MTOK = 65536, DM = 1024, NLAYER = 4, TSEQ = 8192, FF = 2816, NIN = 3840, NGU = 5632;
constexpr size_t MiB = (size_t)1 << 20;
constexpr size_t WS_CTL = 0, WS_W = 1 * MiB, LW = 27262976, LW_IN = 0, LW_OUT = 7864320, LW_GU = 9961472, LW_DN = 21495808;
constexpr size_t WS_XB = 105 * MiB, WS_SS = 233 * MiB, WS_BG = 234 * MiB, WS_PA = 236 * MiB, WS_MIX = 236 * MiB, WS_PZ = 428 * MiB, WS_PS = 492 * MiB, WS_INTER = 684 * MiB, WS_ACT = 236 * MiB, WS_SSP1 = 972 * MiB, WS_SSP2 = 976 * MiB, WS_END = 980 * MiB;
static_assert(WS_W + 4 * LW <= WS_XB, "weights fit");
constexpr int UNIT_BYTES = 73728;
constexpr int LDS_BYTES = 147456;
constexpr float QSCALE = 0.08838834764831845f;

__device__ __forceinline__ float bf2f(unsigned short v) { return __uint_as_float((unsigned)v << 16); }
__device__ __forceinline__ float bflo(unsigned w) { return __uint_as_float(w << 16); }
__device__ __forceinline__ float bfhi(unsigned w) { return __uint_as_float(w & 0xffff0000u); }
__device__ __forceinline__ unsigned short f2bf(float f) { return (unsigned short)(pk_bf16(f, 0.f) & 0xffffu); }
__device__ __forceinline__ float wave_sum(float v) {
#pragma unroll
    for (int o = 1; o < 64; o <<= 1) v += __shfl_xor(v, o);
    return v;
}
__device__ __forceinline__ float sum16(float v) { v += __shfl_xor(v, 1); v += __shfl_xor(v, 2); v += __shfl_xor(v, 4); v += __shfl_xor(v, 8); return v; }
__device__ __forceinline__ constexpr int crow(int reg, int h) { return (reg & 3) + 8 * (reg >> 2) + 4 * h; }
__device__ __forceinline__ bf16x8 pack_step(const f32x16& x, int s) {
    u32x4 p; p.x = pk_bf16(x[8 * s], x[8 * s + 1]); p.y = pk_bf16(x[8 * s + 2], x[8 * s + 3]); p.z = pk_bf16(x[8 * s + 4], x[8 * s + 5]); p.w = pk_bf16(x[8 * s + 6], x[8 * s + 7]);
    return __builtin_bit_cast(bf16x8, p);
}
#define LDS_WAIT() asm volatile("s_waitcnt lgkmcnt(0)" ::: "memory")
#define LDS_BAR() do { asm volatile("s_waitcnt lgkmcnt(0)" ::: "memory"); __builtin_amdgcn_s_barrier(); asm volatile("" ::: "memory"); } while (0)
__device__ __forceinline__ unsigned char* launder_p(unsigned char* p) { asm volatile("" : "+s"(p)); return p; }
__device__ __forceinline__ int launder_i(int i) { asm volatile("" : "+s"(i)); return i; }
#define INP(k) (a.in[launder_i(k)])
__device__ __forceinline__ int launder_v(int i) { asm volatile("" : "+v"(i)); return i; }
__device__ __forceinline__ int fresh_tid(int wave_s) { unsigned ones = ~0u; asm volatile("" : "+s"(ones)); return (wave_s << 6) | (int)__builtin_amdgcn_mbcnt_hi(ones, __builtin_amdgcn_mbcnt_lo(ones, 0u)); }

__device__ __forceinline__ void transpose_item(const float* W, int ldw, int sc, const float* gain, bf16* dst, int K, int k0, LAS float* scr, int lane) {
    float wv[32];
#pragma unroll
    for (int i = 0; i < 32; ++i) { const int kk = 2 * i + (lane >> 5); wv[i] = 0.f; if (sc >= 0) wv[i] = *(const __attribute__((address_space(1))) float*)(W + (size_t)(k0 + kk) * ldw + sc); }
#pragma unroll
    for (int i = 0; i < 32; ++i) { const int kk = 2 * i + (lane >> 5); float v = wv[i]; if (gain) v *= gain[k0 + kk]; scr[kk * 33 + (lane & 31)] = v; }
    LDS_WAIT(); asm volatile("" ::: "memory");
    const int c = lane & 7;
#pragma unroll
    for (int j = 0; j < 4; ++j) { const int n = (lane >> 3) + 8 * j; const LAS float* s = scr + (8 * c) * 33 + n;
        u32x4 o; o.x = pk_bf16(s[0 * 33], s[1 * 33]); o.y = pk_bf16(s[2 * 33], s[3 * 33]); o.z = pk_bf16(s[4 * 33], s[5 * 33]); o.w = pk_bf16(s[6 * 33], s[7 * 33]);
        *(__attribute__((address_space(1))) u32x4*)(dst + (size_t)n * K + k0 + 8 * c) = o; }
    LDS_WAIT(); asm volatile("" ::: "memory");
}

struct Args { const float* in[15]; float* out; unsigned char* ws; };

__device__ __forceinline__ void p0_prologue(const Args& a, LAS unsigned char* lds, int G, int bx, int tid) {
    const int lane = tid & 63, wave = tid >> 6;
    LAS float* scr = (LAS float*)(lds + wave * 16384);
    const int gw = bx * 8 + wave, NGW = G * 8;
    constexpr int I_IN = 16 * 120, I_OUT = 16 * 32, I_GU = 16 * 176, I_DN = 44 * 32, LI = I_IN + I_OUT + I_GU + I_DN;
    unsigned char* wsw = launder_p(a.ws) + WS_W;
    for (int it = gw; it < NLAYER * LI; it += NGW) {
        const int l = it / LI; int r = it % LI; const int cl = lane & 31;
        unsigned char* wl = wsw + (size_t)l * LW;
        if (r < I_IN) { const int kb = r / 120, nb = r % 120, n = nb * 32 + cl;
            const int sc = n < 2048 ? n : (n < 3584 ? n + 8 : (n < 3592 ? n - 3584 + 2048 : -1));
            transpose_item(a.in[2] + (size_t)l * 1024 * 3592, 3592, sc, a.in[1] + l * 1024, (bf16*)(wl + LW_IN) + (size_t)nb * 32 * 1024, 1024, kb * 64, scr, lane); continue; }
        r -= I_IN;
        if (r < I_OUT) { const int kb = r / 32, nb = r % 32;
            transpose_item(a.in[9] + (size_t)l * 1024 * 1024, 1024, nb * 32 + cl, nullptr, (bf16*)(wl + LW_OUT) + (size_t)nb * 32 * 1024, 1024, kb * 64, scr, lane); continue; }
        r -= I_OUT;
        if (r < I_GU) { const int kb = r / 176, nb = r % 176, R0 = nb * 32, pn = R0 >> 8, rr = R0 & 255, bj = rr >> 7, j0 = rr & 127;
            const float* Wsrc = (bj ? a.in[12] : a.in[11]) + (size_t)l * 1024 * 2816;
            transpose_item(Wsrc, 2816, 128 * pn + j0 + cl, a.in[10] + l * 1024, (bf16*)(wl + LW_GU) + (size_t)R0 * 1024, 1024, kb * 64, scr, lane); continue; }
        r -= I_GU;
        { const int kb = r / 32, nb = r % 32;
            transpose_item(a.in[13] + (size_t)l * 2816 * 1024, 1024, nb * 32 + cl, nullptr, (bf16*)(wl + LW_DN) + (size_t)nb * 32 * 2816, 2816, kb * 64, scr, lane); }
    }
    const float* x = a.in[0]; bf16* XB = (bf16*)(a.ws + WS_XB); float* SS1 = (float*)(a.ws + WS_SSP1);
    for (int m = gw; m < MTOK; m += NGW) {
        const f32x4* xr = (const f32x4*)(x + (size_t)m * DM) + lane; f32x4 v[4]; float s = 0.f;
#pragma unroll
        for (int j = 0; j < 4; ++j) { v[j] = xr[64 * j]; s += (v[j].x * v[j].x + v[j].y * v[j].y) + (v[j].z * v[j].z + v[j].w * v[j].w); }
        s = wave_sum(s); if (lane < 16) SS1[(size_t)m * 16 + lane] = lane == 0 ? s : 0.f;
        u32x2* o8 = (u32x2*)(XB + (size_t)m * DM) + lane;
#pragma unroll
        for (int j = 0; j < 4; ++j) { u32x2 o; o.x = pk_bf16(v[j].x, v[j].y); o.y = pk_bf16(v[j].z, v[j].w); o8[64 * j] = o; }
    }
}

constexpr int M1_RAW = 0, M1_AMAT = 0, M1_QKM = 17408, M1_WS = 26624, M1_QS = 51712, M1_KS = 69120, M1_VS = 86528, M1_GC = 103936, M1_BETA = 104192, M1_EG = 104448, M1_BEG = 104704, M1_CW = 106496  , ROWB = 272;

typedef float f32x2v __attribute__((ext_vector_type(2)));
template <int C> struct SolveRows {
    static __device__ __forceinline__ void run(f32x2v (&X2)[32], f32x4 (&cur)[16], LAS unsigned char* lds, const LAS unsigned short* src, const LAS float* fac) {
        f32x4 nxt[16];
#pragma unroll
        for (int q = 0; q < 16; ++q) if (C + 1 < 64 && 4 * q < C + 1) nxt[q] = *(const LAS f32x4*)(lds + M1_AMAT + ((C + 1) * 68 + 4 * q) * 4);
        const float rhs = bf2f(src[C * 136]) * fac[C];
        f32x2v acc0 = {0.f, 0.f}, acc1 = {0.f, 0.f}, acc2 = {0.f, 0.f}, acc3 = {0.f, 0.f};
#pragma unroll
        for (int q = 0; q < 16; ++q) if (4 * q < C) { const f32x4 av = cur[q];
            if (q & 1) { acc2 -= (f32x2v){av.x, av.y} * X2[2 * q]; if (4 * q + 2 < C) acc3 -= (f32x2v){av.z, av.w} * X2[2 * q + 1]; }
            else { acc0 -= (f32x2v){av.x, av.y} * X2[2 * q]; if (4 * q + 2 < C) acc1 -= (f32x2v){av.z, av.w} * X2[2 * q + 1]; } }
        acc0 += acc1; acc2 += acc3; acc0 += acc2;
        float xc = rhs + (acc0.x + acc0.y);
        asm volatile("" : "+v"(xc) :: "memory");
        X2[C >> 1][C & 1] = xc;
#pragma unroll
        for (int q = 0; q < 16; ++q) if (C + 1 < 64 && 4 * q < C + 1) cur[q] = nxt[q];
        if constexpr (C + 1 < 64) SolveRows<C + 1>::run(X2, cur, lds, src, fac);
    }
};

__device__ __forceinline__ void m1_unit(LAS unsigned char* lds, int unit, const bf16* PA, const float* BG, const float* convw, unsigned char* inter, float* glast, int tid_in) {
    int tid = tid_in; asm volatile("" : "+v"(tid));
    const int b = unit >> 9, n = (unit >> 2) & 127, h = unit & 3;
    const int lane = tid & 63, wave = __builtin_amdgcn_readfirstlane(tid >> 6);
    const size_t row0 = (size_t)b * TSEQ + n * 64;
    LAS float* GC = (LAS float*)(lds + M1_GC); LAS float* BETA = (LAS float*)(lds + M1_BETA); LAS float* EG = (LAS float*)(lds + M1_EG); LAS float* BEG = (LAS float*)(lds + M1_BEG);
    unsigned char* ub = inter + (size_t)unit * UNIT_BYTES;
    float bt = 0.f, gv = 0.f;
    if (wave == 0) { const __attribute__((address_space(1))) float* bgp = (const __attribute__((address_space(1))) float*)(BG + (row0 + lane) * 8 + h); bt = bgp[0]; gv = bgp[4]; }
    {
        u32x4 rv[7];
#pragma unroll
        for (int it = 0; it < 7; ++it) {
            const int idx = tid + 512 * it, row = idx / 48, rem = idx % 48, seg = rem >> 4, part = rem & 15, t = n * 64 - 3 + row;
            rv[it] = (u32x4){0u, 0u, 0u, 0u};
            if (idx < 67 * 48 && t >= 0) rv[it] = *(const __attribute__((address_space(1))) u32x4*)(PA + ((size_t)b * TSEQ + t) * 1536 + seg * 512 + h * 128 + part * 8);
        }
#pragma unroll
        for (int it = 0; it < 7; ++it) {
            const int idx = tid + 512 * it, row = idx / 48, rem = idx % 48, seg = rem >> 4, part = rem & 15;
            if (idx < 67 * 48) *(LAS u32x4*)(lds + M1_RAW + row * 768 + seg * 256 + part * 16) = rv[it];
        }
    }
    if (wave == 0) {
#pragma unroll
        for (int off = 1; off < 64; off <<= 1) { const int srcl = lane >= off ? lane - off : lane; const float t = __int_as_float(__builtin_amdgcn_ds_bpermute(srcl << 2, __float_as_int(gv))); if (lane >= off) gv += t; }
        const float eg = __expf(gv);
        GC[lane] = gv; BETA[lane] = bt; EG[lane] = eg; BEG[lane] = bt * eg;
    }
    LDS_BAR();
    {
        const int j = tid & 15, cb = tid >> 4;
#pragma unroll 1
        for (int s = 0; s < 3; ++s) {
            float cw[4][8];
#pragma unroll
            for (int tap = 0; tap < 4; ++tap) { const LAS float* wp = (const LAS float*)(lds + M1_CW) + (h * 4 + tap) * 384 + s * 128 + 8 * j; const f32x4 w0 = *(const LAS f32x4*)wp, w1 = *(const LAS f32x4*)(wp + 4);
                cw[tap][0] = w0.x; cw[tap][1] = w0.y; cw[tap][2] = w0.z; cw[tap][3] = w0.w; cw[tap][4] = w1.x; cw[tap][5] = w1.y; cw[tap][6] = w1.z; cw[tap][7] = w1.w; }
            const int dstoff = s == 0 ? M1_QS : (s == 1 ? M1_KS : M1_VS);
#pragma unroll
            for (int pass = 0; pass < 2; ++pass) {
                const int c = cb + 32 * pass; float y[8];
#pragma unroll
                for (int e = 0; e < 8; ++e) y[e] = 0.f;
#pragma unroll
                for (int tap = 0; tap < 4; ++tap) { const u32x4 xv = *(const LAS u32x4*)(lds + M1_RAW + (c + tap) * 768 + s * 256 + j * 16);
                    y[0] += cw[tap][0] * bflo(xv.x); y[1] += cw[tap][1] * bfhi(xv.x); y[2] += cw[tap][2] * bflo(xv.y); y[3] += cw[tap][3] * bfhi(xv.y);
                    y[4] += cw[tap][4] * bflo(xv.z); y[5] += cw[tap][5] * bfhi(xv.z); y[6] += cw[tap][6] * bflo(xv.w); y[7] += cw[tap][7] * bfhi(xv.w); }
                float ssq = 0.f;
#pragma unroll
                for (int e = 0; e < 8; ++e) { y[e] = y[e] * __builtin_amdgcn_rcpf(1.0f + __expf(-y[e])); ssq += y[e] * y[e]; }
                ssq = sum16(ssq);
                const float rn = (s < 2) ? rsqrtf(ssq + 1e-6f) : 1.0f;
                u32x4 o; o.x = pk_bf16(y[0] * rn, y[1] * rn); o.y = pk_bf16(y[2] * rn, y[3] * rn); o.z = pk_bf16(y[4] * rn, y[5] * rn); o.w = pk_bf16(y[6] * rn, y[7] * rn);
                *(LAS u32x4*)(lds + dstoff + c * ROWB + j * 16) = o;
            }
        }
    }
    LDS_BAR();
    {
        const int r = lane & 31, hh = lane >> 5, w4 = wave & 3, ti = w4 >> 1, tj = w4 & 1; const bool isqk = wave >= 4, upper = (ti == 0 && tj == 1);
        if (isqk || !upper) {
            f32x16 x;
#pragma unroll
            for (int i = 0; i < 16; ++i) x[i] = 0.f;
            if (!upper) {
                const LAS unsigned char* Ab = lds + (isqk ? M1_QS : M1_KS) + (32 * ti + r) * ROWB + hh * 16;
                const LAS unsigned char* Bb = lds + M1_KS + (32 * tj + r) * ROWB + hh * 16;
#pragma unroll
                for (int s = 0; s < 8; ++s) { const bf16x8 av = *(const LAS bf16x8*)(Ab + s * 32), bv = *(const LAS bf16x8*)(Bb + s * 32); x = MFMA32(av, bv, x); }
            }
            const int m = 32 * tj + r; const float gm = GC[m];
            float gcv[16], btv[16];
#pragma unroll
            for (int i = 0; i < 16; ++i) { const int c = 32 * ti + crow(i, hh); gcv[i] = GC[c]; btv[i] = BETA[c]; }
#pragma unroll
            for (int i = 0; i < 16; ++i) { const int c = 32 * ti + crow(i, hh); const float dec = __expf(gcv[i] - gm);
                if (!isqk) { const float val = (m < c) ? btv[i] * x[i] * dec : 0.f; *(LAS float*)(lds + M1_AMAT + (c * 68 + m) * 4) = val; }
                else { const float val = (m <= c) ? x[i] * QSCALE * dec : 0.f; *(LAS unsigned short*)(lds + M1_QKM + (c * 72 + m) * 2) = f2bf(val); } }
        }
    }
    LDS_BAR();
    asm volatile("" : "+v"(tid));
    f32x2v X2[32];
#pragma unroll
    for (int k = 0; k < 32; ++k) X2[k] = (f32x2v){0.f, 0.f};
#define X(i) (X2[(i) >> 1][(i) & 1])
    if (tid < 256) {
        unsigned srcoff = (tid < 128 ? M1_VS : M1_KS) + (tid & 127) * 2, facoff = tid < 128 ? M1_BETA : M1_BEG;
        asm volatile("" : "+v"(srcoff), "+v"(facoff));
        const LAS unsigned short* src = (const LAS unsigned short*)(lds + srcoff);
        const LAS float* fac = (const LAS float*)(lds + facoff);
        f32x4 cur[16];
        SolveRows<0>::run(X2, cur, lds, src, fac);
    } else {
        const int t2 = tid - 256; const float glc = GC[63];
#pragma unroll
        for (int it = 0; it < 4; ++it) {
            const int idx = t2 + 256 * it, frag = idx >> 6, l2 = idx & 63, tt = frag >> 2, ks = frag & 3, nn = l2 & 15, qq = l2 >> 4, c = 16 * tt + nn, dk0 = 32 * ks + 4 * qq;
            const u32x2 p0 = *(const LAS u32x2*)(lds + M1_QS + c * ROWB + dk0 * 2), p1 = *(const LAS u32x2*)(lds + M1_QS + c * ROWB + (dk0 + 16) * 2);
            const float f = QSCALE * EG[c];
            u32x4 o; o.x = pk_bf16(bflo(p0.x) * f, bfhi(p0.x) * f); o.y = pk_bf16(bflo(p0.y) * f, bfhi(p0.y) * f); o.z = pk_bf16(bflo(p1.x) * f, bfhi(p1.x) * f); o.w = pk_bf16(bflo(p1.y) * f, bfhi(p1.y) * f);
            *(__attribute__((address_space(1))) u32x4*)(ub + 16384 + idx * 16) = o;
        }
#pragma unroll
        for (int it = 0; it < 4; ++it) {
            const int idx = t2 + 256 * it, frag = idx >> 6, l2 = idx & 63, t8 = frag >> 1, ks = frag & 1, nn = l2 & 15, qq = l2 >> 4, dk = 16 * t8 + nn;
            float v[8];
#pragma unroll
            for (int e = 0; e < 8; ++e) { const int tok = 32 * ks + 16 * (e >> 2) + 4 * qq + (e & 3); v[e] = bf2f(*(const LAS unsigned short*)(lds + M1_KS + tok * ROWB + dk * 2)) * __expf(glc - GC[tok]); }
            u32x4 o; o.x = pk_bf16(v[0], v[1]); o.y = pk_bf16(v[2], v[3]); o.z = pk_bf16(v[4], v[5]); o.w = pk_bf16(v[6], v[7]);
            *(__attribute__((address_space(1))) u32x4*)(ub + 32768 + idx * 16) = o;
        }
#pragma unroll
        for (int it = 0; it < 2; ++it) {
            const int idx = t2 + 256 * it, frag = idx >> 6, l2 = idx & 63, tt = frag >> 1, ks = frag & 1, nn = l2 & 15, qq = l2 >> 4, c = 16 * tt + nn, m0 = 32 * ks + 4 * qq;
            const u32x2 p0 = *(const LAS u32x2*)(lds + M1_QKM + (c * 72 + m0) * 2), p1 = *(const LAS u32x2*)(lds + M1_QKM + (c * 72 + m0 + 16) * 2);
            u32x4 o; o.x = p0.x; o.y = p0.y; o.z = p1.x; o.w = p1.y;
            *(__attribute__((address_space(1))) u32x4*)(ub + 49152 + idx * 16) = o;
        }
    }
    LDS_BAR();
    asm volatile("" : "+v"(tid));
    if (tid < 128) {
        const int sl = tid >> 4, nn = tid & 15; unsigned char* ubU = ub + 57344 + sl * 2048;
#pragma unroll
        for (int qq = 0; qq < 4; ++qq) {
            u32x4 o0, o1;
            o0.x = pk_bf16(X(4 * qq), X(4 * qq + 1)); o0.y = pk_bf16(X(4 * qq + 2), X(4 * qq + 3)); o0.z = pk_bf16(X(16 + 4 * qq), X(16 + 4 * qq + 1)); o0.w = pk_bf16(X(16 + 4 * qq + 2), X(16 + 4 * qq + 3));
            o1.x = pk_bf16(X(32 + 4 * qq), X(32 + 4 * qq + 1)); o1.y = pk_bf16(X(32 + 4 * qq + 2), X(32 + 4 * qq + 3)); o1.z = pk_bf16(X(48 + 4 * qq), X(48 + 4 * qq + 1)); o1.w = pk_bf16(X(48 + 4 * qq + 2), X(48 + 4 * qq + 3));
            __attribute__((address_space(1))) u32x4* dst = (__attribute__((address_space(1))) u32x4*)(ubU + (qq * 16 + nn) * 32); dst[0] = o0; dst[1] = o1;
        }
    } else if (tid < 256) {
        const int d = tid - 128;
#pragma unroll
        for (int c = 0; c < 64; ++c) *(LAS unsigned short*)(lds + M1_WS + c * ROWB + d * 2) = f2bf(X(c));
    } else if (tid == 256) *(__attribute__((address_space(1))) float*)(glast + unit) = __expf(GC[63]);
    LDS_BAR();
    asm volatile("" : "+v"(tid));
#pragma unroll
    for (int it = 0; it < 2; ++it) {
        const int idx = tid + 512 * it, frag = idx >> 6, l2 = idx & 63, tt = frag >> 2, ks = frag & 3, nn = l2 & 15, qq = l2 >> 4, c = 16 * tt + nn, dk0 = 32 * ks + 4 * qq;
        const u32x2 p0 = *(const LAS u32x2*)(lds + M1_WS + c * ROWB + dk0 * 2), p1 = *(const LAS u32x2*)(lds + M1_WS + c * ROWB + (dk0 + 16) * 2);
        u32x4 o; o.x = p0.x; o.y = p0.y; o.z = p1.x; o.w = p1.y;
        *(__attribute__((address_space(1))) u32x4*)(ub + idx * 16) = o;
    }
    LDS_BAR();
#undef X
}

constexpr int SC_BUF = 61440, SC_CTL = 131072;
#define MFMA16(a, b, c) __builtin_amdgcn_mfma_f32_16x16x32_bf16((a), (b), (c), 0, 0, 0)
__device__ __forceinline__ bf16x8 pack4(const f32x4& a, const f32x4& b) { u32x4 p; p.x = pk_bf16(a[0], a[1]); p.y = pk_bf16(a[2], a[3]); p.z = pk_bf16(b[0], b[1]); p.w = pk_bf16(b[2], b[3]); return __builtin_bit_cast(bf16x8, p); }
__device__ __forceinline__ const unsigned char* scan_piece(const unsigned char* ub, int half, int p) { return ub + (p < 56 ? p * 1024 : 57344 + half * 4096 + (p - 56) * 1024); }
__device__ __forceinline__ void scan_issue(LAS unsigned char* lds, const unsigned char* ub, int half, int buf, int wave, int lane) {
#pragma unroll
    for (int k = 0; k < 8; ++k) { const int p = wave + 8 * k;
        if (p < 60) __builtin_amdgcn_global_load_lds((const unsigned*)(scan_piece(ub, half, p) + lane * 16), (LAS unsigned*)(lds + buf * SC_BUF + p * 1024), 16, 0, 0); }
}
__device__ __forceinline__ void scan_prefetch(LAS unsigned char* lds, const unsigned char* ub, int half, int wave, int lane) {
#pragma unroll
    for (int k = 0; k < 2; ++k) { const int g8 = (wave - 4) * 2 + k;
        const unsigned char* src = ub + (g8 < 7 ? g8 * 8192 : 57344 + half * 4096) + lane * 128;
        __builtin_amdgcn_global_load_lds((const unsigned*)src, (LAS unsigned*)(lds + SC_CTL + 2048 + wave * 1024), 4, 0, 0); }
}
#define FRAG(off) (*(const LAS bf16x8*)(L + (off) + lane * 16))
__device__ __forceinline__ void scan_unit(LAS unsigned char* lds, int bh, int half, const unsigned char* inter, const float* glast, bf16* MIX, int tid) {
    const int wave = __builtin_amdgcn_readfirstlane(tid >> 6), lane = tid & 63, b = bh >> 2, h = bh & 3, nn = lane & 15, qq = lane >> 4;
    f32x4 S[8];
#pragma unroll
    for (int d = 0; d < 8; ++d) S[d] = (f32x4){0.f, 0.f, 0.f, 0.f};
    const int unit0 = (b * 128) * 4 + h;
    LAS float* GLS = (LAS float*)(lds + SC_CTL + 256);
    if (tid < 128) GLS[tid] = glast[unit0 + 4 * tid];
    scan_issue(lds, inter + (size_t)unit0 * UNIT_BYTES, half, 0, wave, lane);
    if (false) { scan_prefetch(lds, inter + (size_t)(unit0 + 4) * UNIT_BYTES, half, wave, lane); scan_prefetch(lds, inter + (size_t)(unit0 + 8) * UNIT_BYTES, half, wave, lane); scan_prefetch(lds, inter + (size_t)(unit0 + 12) * UNIT_BYTES, half, wave, lane); }
    asm volatile("s_waitcnt vmcnt(0)" ::: "memory"); __syncthreads();
#pragma unroll 1
    for (int n = 0; n < 128; ++n) {
        const int buf = n & 1, unit = unit0 + n * 4;
        if (n + 1 < 128) scan_issue(lds, inter + (size_t)(unit + 4) * UNIT_BYTES, half, buf ^ 1, wave, lane);
        const bool pf = false;
        if (pf) scan_prefetch(lds, inter + (size_t)(unit + 16) * UNIT_BYTES, half, wave, lane);
        if (wave < 2) {
            const LAS unsigned char* L = lds + buf * SC_BUF;
            const float gl = GLS[n];
#define SB() __builtin_amdgcn_sched_barrier(0)
            bf16x8 R1[16], R2[16];
#pragma unroll
            for (int t = 0; t < 4; ++t) { R1[2 * t] = FRAG((4 * t) * 1024); R1[2 * t + 1] = FRAG((4 * t + 1) * 1024); R1[8 + 2 * t] = FRAG(16384 + (4 * t) * 1024); R1[8 + 2 * t + 1] = FRAG(16384 + (4 * t + 1) * 1024); }
#pragma unroll
            for (int t = 0; t < 4; ++t) { R2[2 * t] = FRAG((4 * t + 2) * 1024); R2[2 * t + 1] = FRAG((4 * t + 3) * 1024); R2[8 + 2 * t] = FRAG(16384 + (4 * t + 2) * 1024); R2[8 + 2 * t + 1] = FRAG(16384 + (4 * t + 3) * 1024); }
            SB();
            bf16x8 Sb[4];
#pragma unroll
            for (int s = 0; s < 4; ++s) Sb[s] = pack4(S[2 * s], S[2 * s + 1]);
            f32x4 P[4], O[4];
#pragma unroll
            for (int t = 0; t < 4; ++t) { P[t] = (f32x4){0.f, 0.f, 0.f, 0.f}; O[t] = (f32x4){0.f, 0.f, 0.f, 0.f}; }
            SB();
#pragma unroll
            for (int s = 0; s < 2; ++s) {
#pragma unroll
                for (int t = 0; t < 4; ++t) P[t] = MFMA16(R1[2 * t + s], Sb[s], P[t]);
#pragma unroll
                for (int t = 0; t < 4; ++t) O[t] = MFMA16(Sb[s], R1[8 + 2 * t + s], O[t]);
                SB();
            }
#pragma unroll
            for (int d = 0; d < 8; ++d) R1[d] = FRAG(32768 + (2 * d) * 1024);
#pragma unroll
            for (int t = 0; t < 4; ++t) R1[8 + t] = FRAG(49152 + (t * 2) * 1024);
            R1[12] = FRAG(49152 + 5 * 1024); R1[13] = FRAG(49152 + 7 * 1024);
            const LAS u32x4* up = (const LAS u32x4*)(L + 57344 + wave * 2048 + lane * 32);
            const u32x4 u0 = up[0], u1 = up[1];
            SB();
#pragma unroll
            for (int s = 0; s < 2; ++s) {
#pragma unroll
                for (int t = 0; t < 4; ++t) P[t] = MFMA16(R2[2 * t + s], Sb[2 + s], P[t]);
#pragma unroll
                for (int t = 0; t < 4; ++t) O[t] = MFMA16(Sb[2 + s], R2[8 + 2 * t + s], O[t]);
                SB();
            }
#pragma unroll
            for (int d = 0; d < 8; ++d) R2[d] = FRAG(32768 + (2 * d + 1) * 1024);
            SB();
            P[0] = (f32x4){bflo(u0.x), bfhi(u0.x), bflo(u0.y), bfhi(u0.y)} - P[0]; P[1] = (f32x4){bflo(u0.z), bfhi(u0.z), bflo(u0.w), bfhi(u0.w)} - P[1];
            P[2] = (f32x4){bflo(u1.x), bfhi(u1.x), bflo(u1.y), bfhi(u1.y)} - P[2]; P[3] = (f32x4){bflo(u1.z), bfhi(u1.z), bflo(u1.w), bfhi(u1.w)} - P[3];
            bf16x8 Vb[2]; Vb[0] = pack4(P[0], P[1]); Vb[1] = pack4(P[2], P[3]);
#pragma unroll
            for (int d = 0; d < 8; ++d) S[d] = S[d] * gl;
            SB();
#pragma unroll
            for (int d = 0; d < 8; ++d) S[d] = MFMA16(R1[d], Vb[0], S[d]);
#pragma unroll
            for (int t = 0; t < 4; ++t) O[t] = MFMA16(Vb[0], R1[8 + t], O[t]);
            SB();
#pragma unroll
            for (int d = 0; d < 8; ++d) S[d] = MFMA16(R2[d], Vb[1], S[d]);
            O[2] = MFMA16(Vb[1], R1[12], O[2]); O[3] = MFMA16(Vb[1], R1[13], O[3]);
            SB();
            bf16* orow = MIX + ((size_t)b * TSEQ + n * 64 + nn) * 1024 + h * 128 + (half * 2 + wave) * 16 + 4 * qq;
#pragma unroll
            for (int t = 0; t < 4; ++t) { u32x2 o; o.x = pk_bf16(O[t][0], O[t][1]); o.y = pk_bf16(O[t][2], O[t][3]); *(__attribute__((address_space(1))) u32x2*)(orow + (size_t)t * 16 * 1024) = o; }
#undef SB
        }
        if (wave < 2) asm volatile("s_waitcnt vmcnt(4) lgkmcnt(0)" ::: "memory");
        else if (pf) asm volatile("s_waitcnt vmcnt(2) lgkmcnt(0)" ::: "memory");
        else asm volatile("s_waitcnt vmcnt(0) lgkmcnt(0)" ::: "memory");
        __builtin_amdgcn_s_barrier(); asm volatile("" ::: "memory");
    }
    asm volatile("s_waitcnt vmcnt(0) lgkmcnt(0)" ::: "memory"); __syncthreads();
}
#undef FRAG

__device__ __forceinline__ void sc_chunk(int chunk, const bf16* PS, const float* scw, const float* scg, bf16* MIX, int tid) {
    const int wave = tid >> 6, lane = tid & 63, tq = lane >> 4, jj = lane & 15;
#pragma unroll 1
    for (int it = 0; it < 8; ++it) {
        const int wi = wave * 8 + it, quad = wi >> 2, grp = wi & 3;
        const int token = chunk * 64 + quad * 4 + tq, tin = token & (TSEQ - 1), ch = grp * 128 + 8 * jj;
        const bf16* base = PS + (size_t)token * 1536 + ch;
        const u32x4 Bv = *(const u32x4*)base;
        float cv[8];
#pragma unroll
        for (int e = 0; e < 8; ++e) cv[e] = 0.f;
#pragma unroll
        for (int d = 0; d < 3; ++d) {
            if (tin - d >= 0) {
                const u32x4 Cv = *(const __attribute__((address_space(1))) u32x4*)(base - (size_t)d * 1536 + 512), Hv = *(const __attribute__((address_space(1))) u32x4*)(base - (size_t)d * 1536 + 1024);
                const float* wp = scw + (2 - d) * 512 + ch; const f32x4 w0 = *(const f32x4*)wp, w1 = *(const __attribute__((address_space(1))) f32x4*)(wp + 4);
                cv[0] += w0.x * (bflo(Cv.x) * bflo(Hv.x)); cv[1] += w0.y * (bfhi(Cv.x) * bfhi(Hv.x)); cv[2] += w0.z * (bflo(Cv.y) * bflo(Hv.y)); cv[3] += w0.w * (bfhi(Cv.y) * bfhi(Hv.y));
                cv[4] += w1.x * (bflo(Cv.z) * bflo(Hv.z)); cv[5] += w1.y * (bfhi(Cv.z) * bfhi(Hv.z)); cv[6] += w1.z * (bflo(Cv.w) * bflo(Hv.w)); cv[7] += w1.w * (bfhi(Cv.w) * bfhi(Hv.w));
            }
        }
        float y[8] = {bflo(Bv.x) * cv[0], bfhi(Bv.x) * cv[1], bflo(Bv.y) * cv[2], bfhi(Bv.y) * cv[3], bflo(Bv.z) * cv[4], bfhi(Bv.z) * cv[5], bflo(Bv.w) * cv[6], bfhi(Bv.w) * cv[7]};
        float ssq = 0.f;
#pragma unroll
        for (int e = 0; e < 8; ++e) ssq += y[e] * y[e];
        ssq = sum16(ssq);
        const float rn = rsqrtf(ssq * (1.0f / 128.0f) + 1e-6f);
        const f32x4 g0 = *(const __attribute__((address_space(1))) f32x4*)(scg + ch), g1 = *(const __attribute__((address_space(1))) f32x4*)(scg + ch + 4);
        u32x4 o; o.x = pk_bf16(y[0] * rn * g0.x, y[1] * rn * g0.y); o.y = pk_bf16(y[2] * rn * g0.z, y[3] * rn * g0.w); o.z = pk_bf16(y[4] * rn * g1.x, y[5] * rn * g1.y); o.w = pk_bf16(y[6] * rn * g1.z, y[7] * rn * g1.w);
        *(__attribute__((address_space(1))) u32x4*)(MIX + (size_t)token * 1024 + 512 + ch) = o;
    }
}

#define XB_TMO      128
#define XB_XCNT(j)  (256  + 64 * (j))
#define XB_XSUB(j)  (1280 + 64 * (j))
#define XB_XGEN(j)  (2304 + 64 * (j))
#define XB_TOP      3328
#define XB_TOPGEN   3392
#define XCD_BAR_WORDS 3456
#define XB_SPIN_CAP (1u << 18)

__device__ __forceinline__ unsigned xb_ld(unsigned* p)              { return __hip_atomic_load(p, __ATOMIC_RELAXED, __HIP_MEMORY_SCOPE_AGENT); }
__device__ __forceinline__ unsigned xb_add(unsigned* p, unsigned v) { return __hip_atomic_fetch_add(p, v, __ATOMIC_RELAXED, __HIP_MEMORY_SCOPE_AGENT); }
__device__ __forceinline__ unsigned xb_xcc_id() { return (unsigned)__builtin_amdgcn_s_getreg((3 << 11) | 20) & 0xFu; }
#define XB_SPIN(cond, bar) do { unsigned _sp = 0; while (cond) { __builtin_amdgcn_s_sleep(1); \
    if ((++_sp & 255u) == 0u) { if (xb_ld(&(bar)[XB_TMO])) break; if (_sp > XB_SPIN_CAP) { atomicAdd(&(bar)[XB_TMO], 1u); break; } } } } while (0)

struct XcdBarrier {
    unsigned* bar; unsigned x;
    volatile LAS unsigned* st;
};

__device__ __forceinline__ XcdBarrier xcd_barrier_post(unsigned* bar, volatile LAS unsigned* st) {
    XcdBarrier b; b.bar = bar; b.x = xb_xcc_id(); b.st = st;
    if (threadIdx.x == 0) (void)xb_add(&bar[XB_XCNT(b.x)], 1u);
    return b;
}
__device__ __forceinline__ void xcd_barrier_complete(unsigned* bar, unsigned x, unsigned& nloc, unsigned& nx) {
    const unsigned G = gridDim.x * gridDim.y * gridDim.z;
    unsigned sum, cnt, mine, sp = 0u;
    for (;;) {
        sum = 0u; cnt = 0u; mine = 0u;
#pragma unroll
        for (unsigned j = 0; j < 16; ++j) { const unsigned c = xb_ld(&bar[XB_XCNT(j)]); sum += c; cnt += (c > 0u) ? 1u : 0u; mine = (j == x) ? c : mine; }
        if (sum == G) break;
        __builtin_amdgcn_s_sleep(1);
        if ((++sp & 255u) == 0u) { if (xb_ld(&bar[XB_TMO])) break; if (sp > XB_SPIN_CAP) { atomicAdd(&bar[XB_TMO], 1u); break; } }
    }
    nloc = mine > 0u ? mine : 1u; nx = cnt > 0u ? cnt : 1u;
}

__device__ __forceinline__ void xcd_barrier(const XcdBarrier& b) {
    asm volatile("s_waitcnt vmcnt(0)" ::: "memory");
    __syncthreads();
    if (threadIdx.x == 0) {
        unsigned* bar = b.bar;
        __builtin_amdgcn_s_waitcnt(0);
        unsigned nloc = b.st[0], nx = b.st[1];
        if (nloc == 0u) { xcd_barrier_complete(bar, b.x, nloc, nx); b.st[0] = nloc; b.st[1] = nx; }
        const unsigned old = xb_add(&bar[XB_XSUB(b.x)], 1u);
        const unsigned gen = old / nloc;
        if (old + 1u == (gen + 1u) * nloc) {
            __builtin_amdgcn_fence(__ATOMIC_RELEASE, "agent");
            asm volatile("s_waitcnt vmcnt(0)" ::: "memory");
            const unsigned og = xb_add(&bar[XB_TOP], 1u);
            const unsigned tg = og / nx;
            if (og + 1u == (tg + 1u) * nx) xb_add(&bar[XB_TOPGEN], 1u);
            else XB_SPIN(xb_ld(&bar[XB_TOPGEN]) == tg, bar);
            __builtin_amdgcn_fence(__ATOMIC_ACQUIRE, "agent");
            xb_add(&bar[XB_XGEN(b.x)], 1u);
            asm volatile("s_waitcnt vmcnt(0)" ::: "memory");
        } else {
            XB_SPIN(xb_ld(&bar[XB_XGEN(b.x)]) == gen, bar);
            __builtin_amdgcn_fence(__ATOMIC_ACQUIRE, "agent");
            asm volatile("s_waitcnt vmcnt(0)" ::: "memory");
        }
    }
    __syncthreads();
}

#define GRID_BAR() do { XcdBarrier _b; _b.bar = (unsigned*)(launder_p(a.ws) + WS_CTL + 4096); _b.x = xb_xcc_id(); _b.st = (volatile LAS unsigned*)(lds + 131072 + 1024); xcd_barrier(_b); } while (0)
__global__ void __launch_bounds__(512, 2) hybrid_fwd(Args a) {
    extern __shared__ __attribute__((aligned(16))) unsigned char lds_raw[];
    LAS unsigned char* lds = (LAS unsigned char*)lds_raw;
    cg::grid_group grid = cg::this_grid();
    const int tid0 = threadIdx.x;
    if (tid0 < 8) ((LAS unsigned*)(lds + 131072 + 1024))[tid0] = 0u;
    __syncthreads();
    grid.sync();
    (void)xcd_barrier_post((unsigned*)(launder_p(a.ws) + WS_CTL + 4096), (volatile LAS unsigned*)(lds + 131072 + 1024));
    const int wave_s = __builtin_amdgcn_readfirstlane(threadIdx.x >> 6), bx = blockIdx.x, G = gridDim.x;
#define tid fresh_tid(wave_s)
    p0_prologue(a, lds, G, bx, tid);
    GRID_BAR();

#pragma unroll 1
    for (int l = 0; l < NLAYER; ++l) {
#define WSP(off) (launder_p(a.ws) + (off))
        {
            unsigned char* w = launder_p(a.ws);
            pg8::Gemm g{(const bf16*)(w + WS_XB), (const bf16*)(w + WS_W + (size_t)l * LW + LW_IN), MTOK, NIN, DM}; pg8::StaticOrder S; S.init(MTOK, NIN, G, bx);
            pg8::EpiInProj E{(bf16*)(w + WS_PA), (bf16*)(w + WS_PZ), (bf16*)(w + WS_PS), (float*)(w + WS_BG), (const float*)(w + WS_SSP1), INP(4) + l * 4, INP(5) + l * 4};
            for (int rep = 0; rep < PROBE_G1; ++rep)
            pg8::gemm_phase<pg8::EpiInProj, pg8::StaticOrder, true, true>(lds, g, S, E, tid);
        }
        GRID_BAR();
        {
            unsigned char* w = launder_p(a.ws);
            const float* cwp = INP(3) + (size_t)l * 4 * 1536;
            {
                const int t3 = launder_v(tid);
                for (int i = t3; i < 4 * 4 * 384; i += 512) { const int hh = i / 1536, r2 = i % 1536, tap = r2 / 384, c2 = r2 % 384, s2 = c2 >> 7, ch = c2 & 127;
                    ((LAS float*)(lds + M1_CW))[i] = cwp[tap * 1536 + s2 * 512 + hh * 128 + ch]; }
                __syncthreads();
            }
            for (int rep = 0; rep < PROBE_M1; ++rep)
            for (int u = bx; u < 4096; u += G) m1_unit(lds, u, (const bf16*)(w + WS_PA), (const float*)(w + WS_BG), cwp, w + WS_INTER, (float*)(w + WS_SS), tid);
        }
        GRID_BAR();
        for (int rep = 0; rep < PROBE_SCAN; ++rep)
        for (int su = bx; su < 128; su += G) { unsigned char* w = launder_p(a.ws); const int xcd = su & 7, kk = su >> 3; scan_unit(lds, xcd * 4 + (kk >> 2), kk & 3, w + WS_INTER, (const float*)(w + WS_SS), (bf16*)(w + WS_MIX), launder_v(tid)); }
        {
            LAS unsigned* sh = (LAS unsigned*)(lds + 131072);
            unsigned char* w = launder_p(a.ws); unsigned* ctl = (unsigned*)(w + WS_CTL); const bf16* PS = (const bf16*)(w + WS_PS); bf16* MIX = (bf16*)(w + WS_MIX);
            const float* scw = INP(7) + (size_t)l * 3 * 512; const float* scg = INP(8) + (size_t)l * 512;
            for (;;) {
                if (tid == 0) sh[0] = atomicAdd(ctl + 64 * l, 1u);
                LDS_BAR();
                const unsigned c = sh[0];
                LDS_BAR();
                if (c >= 1024u) break;
                sc_chunk((int)c, PS, scw, scg, MIX, launder_v(tid));
            }
        }
        GRID_BAR();
        {
            unsigned char* w = launder_p(a.ws); bf16* MIX = (bf16*)(w + WS_MIX); const bf16* PZ = (const bf16*)(w + WS_PZ);
            const int tid5 = launder_v(tid), G5 = launder_i(G); const float* gn = INP(6) + l * 128; const int jj = tid5 & 15; const f32x4 g0 = *(const f32x4*)(gn + 8 * jj), g1 = *(const f32x4*)(gn + 8 * jj + 4);
            const int istride = (G5 * 512) >> 4;
#pragma unroll 1
            for (int item0 = (bx * 512 + tid5) >> 4; item0 < MTOK * 4; item0 += 4 * istride) {
                u32x4 ov[4], zv[4];
#pragma unroll
                for (int q = 0; q < 4; ++q) { const int item = item0 + q * istride, it2 = item < MTOK * 4 ? item : item0, token = it2 >> 2, hd = it2 & 3;
                    ov[q] = *(const u32x4*)(MIX + (size_t)token * 1024 + hd * 128 + 8 * jj); zv[q] = *(const u32x4*)(PZ + (size_t)token * 512 + hd * 128 + 8 * jj); }
#pragma unroll
                for (int q = 0; q < 4; ++q) { const int item = item0 + q * istride; if (item < MTOK * 4) { const int token = item >> 2, hd = item & 3;
                    float o[8] = {bflo(ov[q].x), bfhi(ov[q].x), bflo(ov[q].y), bfhi(ov[q].y), bflo(ov[q].z), bfhi(ov[q].z), bflo(ov[q].w), bfhi(ov[q].w)};
                    float z[8] = {bflo(zv[q].x), bfhi(zv[q].x), bflo(zv[q].y), bfhi(zv[q].y), bflo(zv[q].z), bfhi(zv[q].z), bflo(zv[q].w), bfhi(zv[q].w)};
                    float ssq = 0.f;
#pragma unroll
                    for (int e = 0; e < 8; ++e) ssq += o[e] * o[e];
                    ssq = sum16(ssq);
                    const float rn = rsqrtf(ssq * (1.0f / 128.0f) + 1e-6f);
                    const float gg[8] = {g0.x, g0.y, g0.z, g0.w, g1.x, g1.y, g1.z, g1.w};
#pragma unroll
                    for (int e = 0; e < 8; ++e) o[e] = o[e] * rn * gg[e] * (z[e] * __builtin_amdgcn_rcpf(1.0f + __expf(-z[e])));
                    u32x4 w; w.x = pk_bf16(o[0], o[1]); w.y = pk_bf16(o[2], o[3]); w.z = pk_bf16(o[4], o[5]); w.w = pk_bf16(o[6], o[7]);
                    *(u32x4*)(MIX + (size_t)token * 1024 + hd * 128 + 8 * jj) = w; } }
            }
        }
        GRID_BAR();
        {
            unsigned char* w = launder_p(a.ws);
            pg8::Gemm g{(const bf16*)(w + WS_MIX), (const bf16*)(w + WS_W + (size_t)l * LW + LW_OUT), MTOK, DM, DM}; pg8::StaticOrder S; S.init(MTOK, DM, G, bx);
            pg8::EpiResid E{(bf16*)(w + WS_XB), (float*)(w + WS_SSP2)};
            pg8::gemm_phase<pg8::EpiResid, pg8::StaticOrder, true, true>(lds, g, S, E, tid);
        }
        GRID_BAR();
        {
            unsigned char* w = launder_p(a.ws);
            pg8::Gemm g{(const bf16*)(w + WS_XB), (const bf16*)(w + WS_W + (size_t)l * LW + LW_GU), MTOK, NGU, DM}; pg8::StaticOrder S; S.init(MTOK, NGU, G, bx);
            pg8::EpiSwiGLU E{(bf16*)(w + WS_ACT), (const float*)(w + WS_SSP2)};
            for (int rep = 0; rep < PROBE_G3; ++rep)
            pg8::gemm_phase<pg8::EpiSwiGLU, pg8::StaticOrder, true, true>(lds, g, S, E, tid);
        }
        GRID_BAR();
        {
            unsigned char* w = launder_p(a.ws);
            pg8::Gemm g{(const bf16*)(w + WS_ACT), (const bf16*)(w + WS_W + (size_t)l * LW + LW_DN), MTOK, DM, FF}; pg8::StaticOrder S; S.init(MTOK, DM, G, bx);
            pg8::EpiResid E{(bf16*)(w + WS_XB), (float*)(w + WS_SSP1)};
            pg8::gemm_phase<pg8::EpiResid, pg8::StaticOrder, true, true>(lds, g, S, E, tid);
        }
        GRID_BAR();
    }
    {
        unsigned char* w = launder_p(a.ws); float* X = (float*)launder_p((unsigned char*)a.out); const float* SS1 = (const float*)(w + WS_SSP1);
        const int tidf = launder_v(tid), lane = tidf & 63;
        const float* gf = INP(14); const int gw = bx * 8 + (tidf >> 6), NGW = G * 8;
        f32x4 gv[4];
#pragma unroll
        for (int j = 0; j < 4; ++j) gv[j] = ((const f32x4*)gf)[lane + 64 * j];
        const bf16* XBf = (const bf16*)(w + WS_XB);
        for (int m = gw; m < MTOK; m += 2 * NGW) {
            const int m2 = m + NGW < MTOK ? m + NGW : m;
            const u32x2* xbr = (const u32x2*)(XBf + (size_t)m * DM) + lane; const u32x2* xbr2 = (const u32x2*)(XBf + (size_t)m2 * DM) + lane;
            u32x2 p[4], p2[4];
#pragma unroll
            for (int j = 0; j < 4; ++j) { p[j] = xbr[64 * j]; p2[j] = xbr2[64 * j]; }
            const float rn = pg8::row_rs(SS1, m), rn2 = pg8::row_rs(SS1, m2);
            f32x4* xr = (f32x4*)(X + (size_t)m * DM) + lane; f32x4* xr2 = (f32x4*)(X + (size_t)m2 * DM) + lane;
#pragma unroll
            for (int j = 0; j < 4; ++j) { f32x4 v = {bflo(p[j].x), bfhi(p[j].x), bflo(p[j].y), bfhi(p[j].y)}; v = v * rn * gv[j]; xr[64 * j] = v; }
            if (m2 != m) {
#pragma unroll
                for (int j = 0; j < 4; ++j) { f32x4 v = {bflo(p2[j].x), bfhi(p2[j].x), bflo(p2[j].y), bfhi(p2[j].y)}; v = v * rn2 * gv[j]; xr2[64 * j] = v; }
            }
        }
    }
}

extern "C" void kernel_launch(void* const* d_in, const int* in_sizes, int n_in, void* d_out, int out_size, void* d_ws, size_t ws_size, hipStream_t stream) {
    static int grid_blocks = 0;
    if (grid_blocks == 0) {
        if (n_in != 15 || in_sizes[0] != MTOK * DM || out_size != MTOK * DM || ws_size < WS_END) { fprintf(stderr, "kernel_launch: unexpected shapes (n_in %d, in0 %d, out %d, ws %zu)\n", n_in, n_in > 0 ? in_sizes[0] : -1, out_size, ws_size); grid_blocks = -1; return; }
        int dev = 0, cus = 0, per_cu = 0;
        hipGetDevice(&dev); hipDeviceGetAttribute(&cus, hipDeviceAttributeMultiprocessorCount, dev);
        if (hipFuncSetAttribute((const void*)hybrid_fwd, hipFuncAttributeMaxDynamicSharedMemorySize, LDS_BYTES) != hipSuccess) { fprintf(stderr, "kernel_launch: hipFuncSetAttribute failed\n"); grid_blocks = -1; return; }
        if (hipOccupancyMaxActiveBlocksPerMultiprocessor(&per_cu, (const void*)hybrid_fwd, 512, LDS_BYTES) != hipSuccess || per_cu < 1) { fprintf(stderr, "kernel_launch: occupancy query gave %d\n", per_cu); per_cu = 1; }
        (void)hipGetLastError();
        grid_blocks = cus * 1;
        fprintf(stderr, "kernel_launch: cus %d per_cu %d grid %d\n", cus, per_cu, grid_blocks);
    }
    if (grid_blocks < 0) return;
    hipMemsetAsync((char*)d_ws + WS_CTL, 0, 4096 + 16384, stream);
    Args a{};
    for (int i = 0; i < 15; ++i) a.in[i] = (const float*)d_in[i];
    a.out = (float*)d_out; a.ws = (unsigned char*)d_ws;
    void* args[] = {&a};
    hipError_t e = hipLaunchCooperativeKernel((const void*)hybrid_fwd, dim3(grid_blocks), dim3(512), args, LDS_BYTES, stream);
    if (e != hipSuccess) fprintf(stderr, "cooperative launch failed: %s (grid %d)\n", hipGetErrorString(e), grid_blocks);
}
```
